# Optimizing an MI355X kernel written in HIP

```python
import math
import numpy as np
import jax
import jax.numpy as jnp
from jax import lax

D_MODEL = 1024
BATCH = 1
SEQ = 16384
DEPTH = 1

ATTN_PATTERNS = ((128, 1), (512, 4), (2048, 16))
N_GROUPS_A = 3
HEADS_PER_GROUP = 4
N_HEADS_A = N_GROUPS_A * HEADS_PER_GROUP
HEAD_DIM_A = 128
D_ATTN = N_HEADS_A * HEAD_DIM_A
D_ATTN_OUT = HEADS_PER_GROUP * HEAD_DIM_A
BLOCK_A = 128
N_HEADS_B = 8
HEAD_DIM_K = 128
HEAD_DIM_V = 128
D_KEY_B = N_HEADS_B * HEAD_DIM_K
D_VAL_B = N_HEADS_B * HEAD_DIM_V
CONV_WIDTH = 4
CHUNK = 64
N_BRANCHES = 2
D_FF = ((8 * D_MODEL // 3 + 255) // 256) * 256
EPS = 1e-6
IN_SPLITS = (D_ATTN, D_ATTN, D_ATTN, D_KEY_B, D_KEY_B, D_VAL_B, D_VAL_B, N_HEADS_B, N_HEADS_B, N_BRANCHES * D_MODEL)
D_IN = 3 * D_ATTN + 2 * D_KEY_B + 2 * D_VAL_B + 2 * N_HEADS_B + N_BRANCHES * D_MODEL

kernel_name = 'hybrid_dilated_swa_gated_deltanet'


def rmsnorm(x, w):
    xf = x.astype(jnp.float32)
    xf = xf * lax.rsqrt(jnp.mean(xf * xf, axis=-1, keepdims=True) + EPS)
    return xf.astype(x.dtype) * w


def l2norm(t):
    return t * lax.rsqrt(jnp.sum(t * t, axis=-1, keepdims=True) + EPS)


def alibi_slopes():
    return jnp.exp2(-8.0 * jnp.arange(1, N_HEADS_A + 1, dtype=jnp.float32) / N_HEADS_A)


def dilated_window_attention(q, k, v, slopes, window, dilation):
    b, s, h, dh = q.shape
    f32 = jnp.float32
    w_sub = window // dilation
    span = BLOCK_A * dilation
    s_pad = -(-s // span) * span
    nb = s_pad // span

    def to_blocks(t):
        t = jnp.pad(t, ((0, 0), (0, s_pad - s), (0, 0), (0, 0)))
        return t.reshape(b, nb, BLOCK_A, dilation, h, dh)

    qb, kb, vb = to_blocks(q), to_blocks(k), to_blocks(v)

    def with_prev(t):
        prev = jnp.pad(t[:, :-1], ((0, 0), (1, 0), (0, 0), (0, 0), (0, 0), (0, 0)))
        return jnp.concatenate([prev, t], axis=2)

    kc, vc = with_prev(kb), with_prev(vb)
    scores = jnp.einsum('bnirhd,bnjrhd->bnrhij', qb, kc).astype(f32) * (dh ** -0.5)
    i = jnp.arange(BLOCK_A)[:, None]
    j = jnp.arange(2 * BLOCK_A)[None, :]
    delta = BLOCK_A + i - j
    band = (delta >= 0) & (delta <= w_sub)
    has_prev = (jnp.arange(nb)[:, None, None] > 0) | (j >= BLOCK_A)[None]
    valid = band[None] & has_prev
    bias = -(slopes.astype(f32) * dilation)[:, None, None] * delta.astype(f32)
    scores = jnp.where(valid[None, :, None, None], scores + bias, -jnp.inf)
    m = jnp.max(scores, axis=-1, keepdims=True)
    p = jnp.exp(scores - m)
    den = jnp.sum(p, axis=-1)
    o = jnp.einsum('bnrhij,bnjrhd->bnirhd', p, vc.astype(f32))
    o = o / jnp.transpose(den, (0, 1, 4, 2, 3))[..., None]
    lse = jnp.transpose(m[..., 0] + jnp.log(den), (0, 1, 4, 2, 3))
    o = o.reshape(b, s_pad, h, dh)[:, :s]
    lse = lse.reshape(b, s_pad, h)[:, :s]
    return o, lse


def causal_depthwise_conv(x, w):
    c = x.shape[-1]
    return lax.conv_general_dilated(x, w[:, None, :].astype(x.dtype), window_strides=(1,),
                                    padding=((CONV_WIDTH - 1, 0),),
                                    dimension_numbers=('NWC', 'WIO', 'NWC'),
                                    feature_group_count=c)


def gated_delta_rule(q, k, v, g, beta):
    b, s, h, dk = q.shape
    dv = v.shape[-1]
    n = s // CHUNK

    def chunks(t):
        return jnp.moveaxis(t.reshape(b, n, CHUNK, h, -1), 3, 1)

    q, k, v = chunks(q), chunks(k), chunks(v)
    g = jnp.moveaxis(g.reshape(b, n, CHUNK, h), 3, 1)
    beta = jnp.moveaxis(beta.reshape(b, n, CHUNK, h), 3, 1)
    gc = jnp.cumsum(g, axis=-1)
    incl = jnp.tril(jnp.ones((CHUNK, CHUNK), dtype=bool))
    strict = jnp.tril(jnp.ones((CHUNK, CHUNK), dtype=bool), -1)
    decay = jnp.exp(jnp.where(incl, gc[..., :, None] - gc[..., None, :], -jnp.inf))
    kk = jnp.einsum('bhnid,bhnjd->bhnij', k, k)
    a = jnp.where(strict, beta[..., :, None] * kk * decay, 0.0)
    eye = jnp.eye(CHUNK, dtype=a.dtype)
    rhs = jnp.concatenate([beta[..., None] * v, (beta * jnp.exp(gc))[..., None] * k], axis=-1)
    sol = lax.linalg.triangular_solve(eye + a, rhs, left_side=True, lower=True, unit_diagonal=True)
    u_bar, w = sol[..., :dv], sol[..., dv:]
    qk = jnp.einsum('bhnid,bhnjd->bhnij', q, k) * decay
    q_dec = q * jnp.exp(gc)[..., None]
    k_dec = k * jnp.exp(gc[..., -1:] - gc)[..., None]
    g_last = jnp.exp(gc[..., -1])

    def step(state, xs):
        u_bar_c, w_c, qk_c, q_c, k_c, gl_c = xs
        u = u_bar_c - jnp.einsum('bhck,bhkv->bhcv', w_c, state)
        o = jnp.einsum('bhck,bhkv->bhcv', q_c, state) + jnp.einsum('bhcj,bhjv->bhcv', qk_c, u)
        state = gl_c[..., None, None] * state + jnp.einsum('bhck,bhcv->bhkv', k_c, u)
        return state, o

    xs = tuple(jnp.moveaxis(t, 2, 0) for t in (u_bar, w, qk, q_dec, k_dec, g_last))
    state0 = jnp.zeros((b, h, dk, dv), jnp.float32)
    _, o = lax.scan(step, state0, xs)
    return jnp.transpose(o, (1, 0, 3, 2, 4)).reshape(b, s, h, dv)


def setup_inputs(seed: int = 0) -> dict:
    key = jax.random.key(seed)
    ks = jax.random.split(key, 16)
    f32 = jnp.float32

    def nrm(k, shape, fan_in):
        return jax.random.normal(k, shape, f32) * (fan_in ** -0.5)

    def gain(k, shape):
        return 1.0 + 0.02 * jax.random.normal(k, shape, f32)

    x = jax.random.normal(ks[0], (BATCH, SEQ, D_MODEL), f32)
    a_log = jnp.log(jax.random.uniform(ks[4], (DEPTH, N_HEADS_B), f32, minval=1.0, maxval=16.0))
    dt = jnp.exp(jax.random.uniform(ks[5], (DEPTH, N_HEADS_B), f32, minval=math.log(1e-3), maxval=math.log(1e-1)))
    dt_bias = dt + jnp.log(-jnp.expm1(-dt))
    return {
        'x': x,
        'norm_mix': gain(ks[1], (DEPTH, D_MODEL)),
        'w_in': nrm(ks[2], (DEPTH, D_MODEL, D_IN), D_MODEL),
        'conv_w': nrm(ks[3], (DEPTH, CONV_WIDTH, 2 * D_KEY_B + D_VAL_B), CONV_WIDTH),
        'a_log': a_log,
        'dt_bias': dt_bias,
        'dn_norm': gain(ks[6], (DEPTH, HEAD_DIM_V)),
        'w_proj_attn': nrm(ks[7], (DEPTH, D_ATTN_OUT, D_MODEL), D_ATTN_OUT),
        'w_proj_delta': nrm(ks[8], (DEPTH, D_VAL_B, D_MODEL), D_VAL_B),
        'w_out': nrm(ks[9], (DEPTH, D_MODEL, D_MODEL), D_MODEL),
        'norm_ffn': gain(ks[10], (DEPTH, D_MODEL)),
        'w_gate': nrm(ks[11], (DEPTH, D_MODEL, D_FF), D_MODEL),
        'w_up': nrm(ks[12], (DEPTH, D_MODEL, D_FF), D_MODEL),
        'w_down': nrm(ks[13], (DEPTH, D_FF, D_MODEL), D_FF),
        'norm_final': gain(ks[14], (D_MODEL,)),
    }


def reference(x, norm_mix, w_in, conv_w, a_log, dt_bias, dn_norm, w_proj_attn, w_proj_delta,
              w_out, norm_ffn, w_gate, w_up, w_down, norm_final):
    b, s, _ = x.shape
    f32 = jnp.float32
    slopes = alibi_slopes()
    split_at = np.cumsum(IN_SPLITS)[:-1].tolist()
    h = x
    for layer in range(DEPTH):
        u = rmsnorm(h, norm_mix[layer])
        proj = u @ w_in[layer]
        qa, ka, va, qd, kd, vd, z, beta_raw, a_raw, gate_raw = jnp.split(proj, split_at, axis=-1)

        qa = qa.reshape(b, s, N_HEADS_A, HEAD_DIM_A)
        ka = ka.reshape(b, s, N_HEADS_A, HEAD_DIM_A)
        va = va.reshape(b, s, N_HEADS_A, HEAD_DIM_A)
        outs, lses = [], []
        for gi, (window, dilation) in enumerate(ATTN_PATTERNS):
            hs = slice(gi * HEADS_PER_GROUP, (gi + 1) * HEADS_PER_GROUP)
            o, lse = dilated_window_attention(qa[:, :, hs], ka[:, :, hs], va[:, :, hs], slopes[hs], window, dilation)
            outs.append(o)
            lses.append(lse)
        mix_w = jax.nn.softmax(jnp.stack(lses), axis=0)
        y_a = jnp.einsum('gbsh,gbshd->bshd', mix_w, jnp.stack(outs)).reshape(b, s, D_ATTN_OUT).astype(x.dtype)
        y_a = y_a @ w_proj_attn[layer]

        qkv = jax.nn.silu(causal_depthwise_conv(jnp.concatenate([qd, kd, vd], axis=-1), conv_w[layer]))
        qd, kd, vd = jnp.split(qkv, [D_KEY_B, 2 * D_KEY_B], axis=-1)
        qd = l2norm(qd.reshape(b, s, N_HEADS_B, HEAD_DIM_K).astype(f32)) * (HEAD_DIM_K ** -0.5)
        kd = l2norm(kd.reshape(b, s, N_HEADS_B, HEAD_DIM_K).astype(f32))
        vd = vd.reshape(b, s, N_HEADS_B, HEAD_DIM_V).astype(f32)
        beta = jax.nn.sigmoid(beta_raw.astype(f32))
        g = -jnp.exp(a_log[layer].astype(f32)) * jax.nn.softplus(a_raw.astype(f32) + dt_bias[layer].astype(f32))
        o_d = gated_delta_rule(qd, kd, vd, g, beta)
        o_d = rmsnorm(o_d, dn_norm[layer].astype(f32)) * jax.nn.silu(z.reshape(b, s, N_HEADS_B, HEAD_DIM_V).astype(f32))
        y_b = o_d.reshape(b, s, D_VAL_B).astype(x.dtype) @ w_proj_delta[layer]

        gate_a, gate_b = jnp.split(jax.nn.sigmoid(gate_raw), N_BRANCHES, axis=-1)
        h = h + (gate_a * y_a + gate_b * y_b) @ w_out[layer]

        hn = rmsnorm(h, norm_ffn[layer])
        h = h + (jax.nn.silu(hn @ w_gate[layer]) * (hn @ w_up[layer])) @ w_down[layer]
    return rmsnorm(h, norm_final)
```

```cpp
#include <hip/hip_runtime.h>
#include <cstdio>
#include <cstdint>
namespace pg8 {
#define PG8_LAS __attribute__((address_space(3)))
typedef unsigned short bf16_t;
typedef short bf16x8 __attribute__((ext_vector_type(8)));
typedef float f32x4 __attribute__((ext_vector_type(4)));
typedef unsigned u32x4 __attribute__((ext_vector_type(4)));
constexpr int BM = 256, BK = 64, HALF = 128, HTB = HALF * BK * 2  , STAGE_BYTES = 8 * HTB, NXCD = 8, WGM = 8;

__host__ __device__ __forceinline__ int lds_byte(int r, int c) { const int st = (r >> 4) * 2 + (c >> 5), rr = r & 15, cc = c & 31, ob = rr * 64 + cc * 2; return st * 1024 + (ob ^ (((ob >> 9) & 1) << 5)); }
__host__ __device__ __forceinline__ void stage_rc(int b, int& R, int& C) { const int st = b / 1024, sb = b % 1024, swz = sb ^ (((sb >> 9) & 1) << 5); R = (st >> 1) * 16 + swz / 64; C = (st & 1) * 32 + (swz % 64) / 2; }
__host__ __device__ __forceinline__ int perm32(int rho) { const int n = rho >> 4, i = rho & 15; return 8 * (i >> 2) + 4 * n + (i & 3); }

struct Unit { int pm, pn; };
struct Gemm { const bf16_t* A; const bf16_t* Bt; int M, N, K; };

struct StaticOrder {
    int nM, nN, nwg, G, c;
    __host__ __device__ void init(int M, int N, int G_, int c_) { nM = M / BM; nN = N / BM; nwg = nM * nN; G = G_; c = c_; }
    __host__ __device__ bool next(int i, Unit& u) const {
        const long L = (long)i * G + c; if (L >= nwg) return false;
        int wgid = (int)L; { const int q = nwg / NXCD, r = nwg % NXCD, xcd = wgid % NXCD, off = wgid / NXCD; wgid = (xcd < r ? xcd * (q + 1) : r * (q + 1) + (xcd - r) * q) + off; }
        const int nig = WGM * nN, gid = wgid / nig, fm = gid * WGM, gsz = (nM - fm) < WGM ? (nM - fm) : WGM;
        u.pm = fm + ((wgid % nig) % gsz); u.pn = (wgid % nig) / gsz; return true;
    }
    __device__ __forceinline__ void a_ready(const Unit&) const {}
    __device__ __forceinline__ void done(const Unit&) const {}
};

__device__ __forceinline__ unsigned cvt_pk_bf16(float lo, float hi) { unsigned r; asm volatile("v_cvt_pk_bf16_f32 %0, %1, %2" : "=v"(r) : "v"(lo), "v"(hi)); return r; }
typedef float f32x2 __attribute__((ext_vector_type(2)));
typedef unsigned u32x2 __attribute__((ext_vector_type(2)));
typedef float f32x2c __attribute__((ext_vector_type(2))); typedef __bf16 bf16x2c __attribute__((ext_vector_type(2)));
__device__ __forceinline__ unsigned cvt2(float lo, float hi) { f32x2c v = {lo, hi}; bf16x2c b = __builtin_convertvector(v, bf16x2c); return __builtin_bit_cast(unsigned, b); }
__device__ __forceinline__ u32x4 pack8(const f32x4 a, const f32x4 b) { u32x4 w; w.x = cvt2(a[0], a[1]); w.y = cvt2(a[2], a[3]); w.z = cvt2(b[0], b[1]); w.w = cvt2(b[2], b[3]); return w; }
__device__ __forceinline__ float bf_lo(unsigned w) { return __uint_as_float(w << 16); }
__device__ __forceinline__ float bf_hi(unsigned w) { return __uint_as_float(w & 0xffff0000u); }
__device__ __forceinline__ float sigmoidf_(float x) { return 1.0f / (1.0f + __expf(-x)); }
__device__ __forceinline__ float siluf_(float x) { return x / (1.0f + __expf(-x)); }

struct EpiStore {
    static constexpr bool PERM = true, AFTER_DRAIN = false;
    bf16_t* O; int ldc;
    __device__ __forceinline__ void operator()(const f32x4 (&acc)[2][2][4][2], const Unit& u, int wr, int wc, int fr, int fq) const {
        const int row0 = u.pm * BM + wr * 64 + fr, col0 = u.pn * BM + wc * 32 + 8 * fq;
#pragma unroll
        for (int ai = 0; ai < 2; ++ai)
#pragma unroll
            for (int m = 0; m < 4; ++m) { bf16_t* rowp = O + (size_t)(row0 + ai * HALF + m * 16) * ldc + col0;
#pragma unroll
                for (int bj = 0; bj < 2; ++bj) *(u32x4*)(rowp + bj * HALF) = pack8(acc[ai][bj][m][0], acc[ai][bj][m][1]); }
    }
};
struct EpiQkvd {
    static constexpr bool PERM = true, AFTER_DRAIN = false;
    bf16_t* QKVD; bf16_t* HALO; bf16_t* Z;
    __device__ __forceinline__ void operator()(const f32x4 (&acc)[2][2][4][2], const Unit& u, int wr, int wc, int fr, int fq) const {
        const int row0 = u.pm * BM + wr * 64 + fr;
        if (u.pn < 12) {
            const int col0 = u.pn * BM + wc * 32 + 8 * fq;
#pragma unroll
            for (int ai = 0; ai < 2; ++ai)
#pragma unroll
                for (int m = 0; m < 4; ++m) { const int row = row0 + ai * HALF + m * 16; bf16_t* rowp = QKVD + (size_t)row * 3072 + col0;
                    const int rc = row & 63;
#pragma unroll
                    for (int bj = 0; bj < 2; ++bj) { const u32x4 w = pack8(acc[ai][bj][m][0], acc[ai][bj][m][1]); *(u32x4*)(rowp + bj * HALF) = w;
                        if (rc >= 61) *(u32x4*)(HALO + ((size_t)(row >> 6) * 3 + (rc - 61)) * 3072 + col0 + bj * HALF) = w; } }
        } else {
            const int col0 = (u.pn - 12) * BM + wc * 32 + 8 * fq;
#pragma unroll
            for (int ai = 0; ai < 2; ++ai)
#pragma unroll
                for (int m = 0; m < 4; ++m) { bf16_t* rowp = Z + (size_t)(row0 + ai * HALF + m * 16) * 1024 + col0;
#pragma unroll
                    for (int bj = 0; bj < 2; ++bj) { f32x4 a = acc[ai][bj][m][0], b = acc[ai][bj][m][1];
#pragma unroll
                        for (int i = 0; i < 4; ++i) { a[i] = siluf_(a[i]); b[i] = siluf_(b[i]); }
                        *(u32x4*)(rowp + bj * HALF) = pack8(a, b); } }
        }
    }
};
struct EpiGateMerge {
    static constexpr bool PERM = true, AFTER_DRAIN = false;
    bf16_t* T1; const bf16_t* T2;
    __device__ __forceinline__ void operator()(const f32x4 (&acc)[2][2][4][2], const Unit& u, int wr, int wc, int fr, int fq) const {
        const int row0 = u.pm * BM + wr * 64 + fr, col0 = u.pn * HALF + wc * 32 + 8 * fq;
#pragma unroll
        for (int ai = 0; ai < 2; ++ai)
#pragma unroll
            for (int m = 0; m < 4; ++m) { const size_t off = (size_t)(row0 + ai * HALF + m * 16) * 1024 + col0;
                const u32x4 a = *(const u32x4*)(T1 + off), b = *(const u32x4*)(T2 + off);
                f32x4 o0, o1;
#pragma unroll
                for (int i = 0; i < 2; ++i) {
                    o0[2 * i]     = sigmoidf_(acc[ai][0][m][0][2 * i])     * bf_lo(a[i])     + sigmoidf_(acc[ai][1][m][0][2 * i])     * bf_lo(b[i]);
                    o0[2 * i + 1] = sigmoidf_(acc[ai][0][m][0][2 * i + 1]) * bf_hi(a[i])     + sigmoidf_(acc[ai][1][m][0][2 * i + 1]) * bf_hi(b[i]);
                    o1[2 * i]     = sigmoidf_(acc[ai][0][m][1][2 * i])     * bf_lo(a[2 + i]) + sigmoidf_(acc[ai][1][m][1][2 * i])     * bf_lo(b[2 + i]);
                    o1[2 * i + 1] = sigmoidf_(acc[ai][0][m][1][2 * i + 1]) * bf_hi(a[2 + i]) + sigmoidf_(acc[ai][1][m][1][2 * i + 1]) * bf_hi(b[2 + i]); }
                *(u32x4*)(T1 + off) = pack8(o0, o1); }
    }
};
struct EpiResid {
    static constexpr bool PERM = true, AFTER_DRAIN = false;
    const float* BASE; float* OUT; bf16_t* HB; float* SSQ;
    __device__ __forceinline__ void operator()(const f32x4 (&acc)[2][2][4][2], const Unit& u, int wr, int wc, int fr, int fq) const {
        const int row0 = u.pm * BM + wr * 64 + fr, col0 = u.pn * BM + wc * 32 + 8 * fq;
#pragma unroll
        for (int ai = 0; ai < 2; ++ai)
#pragma unroll
            for (int m = 0; m < 4; ++m) { const int row = row0 + ai * HALF + m * 16; const size_t off = (size_t)row * 1024 + col0; float ss = 0.f;
#pragma unroll
                for (int bj = 0; bj < 2; ++bj) {
                    const f32x4 b0 = *(const f32x4*)(BASE + off + bj * HALF), b1 = *(const f32x4*)(BASE + off + bj * HALF + 4);
                    const f32x4 h0 = b0 + acc[ai][bj][m][0], h1 = b1 + acc[ai][bj][m][1];
                    ss += (h0[0] * h0[0] + h0[1] * h0[1]) + (h0[2] * h0[2] + h0[3] * h0[3]) + (h1[0] * h1[0] + h1[1] * h1[1]) + (h1[2] * h1[2] + h1[3] * h1[3]);
                    *(f32x4*)(OUT + off + bj * HALF) = h0; *(f32x4*)(OUT + off + bj * HALF + 4) = h1;
                    if (HB) *(u32x4*)(HB + off + bj * HALF) = pack8(h0, h1); }
                ss += __shfl_xor(ss, 16); ss += __shfl_xor(ss, 32);
                if (fq == 0) SSQ[(size_t)row * 16 + u.pn * 4 + wc] = ss; }
    }
};
struct EpiSwiglu {
    static constexpr bool PERM = true, AFTER_DRAIN = false;
    bf16_t* ACT; const float* SSQ; float eps;
    __device__ __forceinline__ void operator()(const f32x4 (&acc)[2][2][4][2], const Unit& u, int wr, int wc, int fr, int fq) const {
        const int row0 = u.pm * BM + wr * 64 + fr, col0 = u.pn * HALF + wc * 32 + 8 * fq;
#pragma unroll
        for (int ai = 0; ai < 2; ++ai)
#pragma unroll
            for (int m = 0; m < 4; ++m) { const int row = row0 + ai * HALF + m * 16;
                const f32x4* sp = (const f32x4*)(SSQ + (size_t)row * 16); const f32x4 s0 = sp[0], s1 = sp[1], s2 = sp[2], s3 = sp[3];
                const float ss = ((s0[0] + s0[1]) + (s0[2] + s0[3])) + ((s1[0] + s1[1]) + (s1[2] + s1[3])) + ((s2[0] + s2[1]) + (s2[2] + s2[3])) + ((s3[0] + s3[1]) + (s3[2] + s3[3]));
                const float rs = 1.0f / sqrtf(ss * (1.0f / 1024.0f) + eps);
                f32x4 o0, o1;
#pragma unroll
                for (int i = 0; i < 4; ++i) { o0[i] = siluf_(acc[ai][0][m][0][i] * rs) * (acc[ai][1][m][0][i] * rs); o1[i] = siluf_(acc[ai][0][m][1][i] * rs) * (acc[ai][1][m][1][i] * rs); }
                *(u32x4*)(ACT + (size_t)row * 2816 + col0) = pack8(o0, o1); }
    }
};
template <class Epi, class Sched, bool ALIGN_EPI = false, bool SP2 = false>
__device__ __forceinline__ void gemm_phase(PG8_LAS unsigned char* lds, const Gemm g, const Sched& S, const Epi& E) {
    const int tid = threadIdx.x, wid = __builtin_amdgcn_readfirstlane(tid >> 6), lane = tid & 63, wr = wid >> 2, wc = wid & 3, fr = lane & 15, fq = lane >> 4;
    const int K = g.K, nt = K / BK;
    unsigned voffA[2], voffB[2];
#pragma unroll
    for (int i = 0; i < 2; ++i) { int R, C; stage_rc(tid * 16 + i * 8192, R, C); const int Rb = Epi::PERM ? ((R & ~31) + perm32(R & 31)) : R;
        voffA[i] = (unsigned)(R * K + C) * 2u; voffB[i] = (unsigned)(Rb * K + C) * 2u; }
    const size_t kstep = (size_t)(BK * 2);
    const size_t hstep = (size_t)HALF * K * 2;
    const size_t tstep = 2 * hstep;
    const unsigned ldsw = (unsigned)wid * 1024u;
    const int aoff = lds_byte(wr * 64 + fr, fq * 8), boff = lds_byte(wc * 32 + fr, fq * 8);
#define PG8_SA(b, h) (((b) * 2 + (h)) * HTB)
#define PG8_SB(b, h) ((4 + (b) * 2 + (h)) * HTB)
#define PG8_STAGE(bufoff, gbase, voff) do { _Pragma("unroll") for (int _i = 0; _i < 2; ++_i) \
        __builtin_amdgcn_global_load_lds((const unsigned*)((const char*)(gbase) + (voff)[_i]), (PG8_LAS unsigned*)(lds + (bufoff) + ldsw + _i * 8192), 16, 0, 0); } while (0)
#define PG8_LDA(dst, b, h) do { _Pragma("unroll") for (int m = 0; m < 4; ++m) _Pragma("unroll") for (int k = 0; k < 2; ++k) dst[m][k] = *(const PG8_LAS bf16x8*)(lds + PG8_SA(b, h) + aoff + m * 2048 + k * 1024); } while (0)
#define PG8_LDB(dst, b, h) do { _Pragma("unroll") for (int n = 0; n < 2; ++n) _Pragma("unroll") for (int k = 0; k < 2; ++k) dst[n][k] = *(const PG8_LAS bf16x8*)(lds + PG8_SB(b, h) + boff + n * 2048 + k * 1024); } while (0)
#define PG8_MMA(ai, bj, At, Bt) do { __builtin_amdgcn_s_setprio(1); _Pragma("unroll") for (int m = 0; m < 4; ++m) _Pragma("unroll") for (int n = 0; n < 2; ++n) _Pragma("unroll") for (int k = 0; k < 2; ++k) \
        acc[ai][bj][m][n] = __builtin_amdgcn_mfma_f32_16x16x32_bf16(Bt[n][k], At[m][k], acc[ai][bj][m][n], 0, 0, 0); __builtin_amdgcn_s_setprio(0); } while (0)
#define PG8_WAIT_V(n) asm volatile("s_waitcnt vmcnt(" #n ")" ::: "memory")
#define PG8_WAIT_L(n) asm volatile("s_waitcnt lgkmcnt(" #n ")" ::: "memory")
#define PG8_BAR __builtin_amdgcn_s_barrier()
#define PG8_SCHED __builtin_amdgcn_sched_barrier(0)
    Unit cur, nxt; int ui = 0;
    if (!S.next(0, cur)) return;
    f32x4 acc[2][2][4][2];
#pragma unroll
    for (int a = 0; a < 2; ++a)
#pragma unroll
        for (int b = 0; b < 2; ++b)
#pragma unroll
            for (int m = 0; m < 4; ++m)
#pragma unroll
                for (int n = 0; n < 2; ++n) acc[a][b][m][n] = (f32x4){0.f, 0.f, 0.f, 0.f};
    bf16x8 At[4][2], B0[2][2], B1[2][2];
    const char* cA = (const char*)g.A + (size_t)cur.pm * tstep; const char* cB = (const char*)g.Bt + (size_t)cur.pn * tstep;
    S.a_ready(cur);
    if constexpr (SP2) {
        PG8_STAGE(PG8_SB(0, 0), cB, voffB); PG8_STAGE(PG8_SB(0, 1), cB + hstep, voffB); PG8_STAGE(PG8_SA(0, 0), cA, voffA); PG8_STAGE(PG8_SA(0, 1), cA + hstep, voffA);
        if (wr == 1) PG8_BAR;
        PG8_WAIT_V(2); PG8_BAR;
        PG8_STAGE(PG8_SB(1, 0), cB + kstep, voffB); PG8_STAGE(PG8_SA(1, 0), cA + kstep, voffA); PG8_STAGE(PG8_SB(1, 1), cB + hstep + kstep, voffB);
        PG8_WAIT_V(6); PG8_BAR;
    } else {
        PG8_STAGE(PG8_SB(0, 0), cB, voffB); PG8_STAGE(PG8_SA(0, 0), cA, voffA); PG8_STAGE(PG8_SB(0, 1), cB + hstep, voffB); PG8_STAGE(PG8_SA(0, 1), cA + hstep, voffA);
        if (wr == 1) PG8_BAR;
        PG8_WAIT_V(4); PG8_BAR;
        PG8_STAGE(PG8_SB(1, 0), cB + kstep, voffB); PG8_STAGE(PG8_SA(1, 0), cA + kstep, voffA); PG8_STAGE(PG8_SB(1, 1), cB + hstep + kstep, voffB);
        PG8_WAIT_V(6); PG8_BAR;
    }
    for (;;) {
        const bool has_next = S.next(ui + 1, nxt);
        const char* nA = has_next ? (const char*)g.A + (size_t)nxt.pm * tstep : cA; const char* nB = has_next ? (const char*)g.Bt + (size_t)nxt.pn * tstep : cB;
        for (int t = 0; t < nt; t += 2) {
            const bool last = (t == nt - 2);
            const char* a1 = cA + (size_t)(t + 1) * kstep;
            const char* a2 = last ? nA : cA + (size_t)(t + 2) * kstep; const char* b2 = last ? nB : cB + (size_t)(t + 2) * kstep;
            const char* a3 = a2 + kstep; const char* b3 = b2 + kstep;
            if (last && has_next) S.a_ready(nxt);
            if constexpr (SP2) {
            PG8_LDB(B0, 0, 0); PG8_LDB(B1, 0, 1); PG8_SCHED; PG8_LDA(At, 0, 0); PG8_STAGE(PG8_SA(1, 1), a1 + hstep, voffA);
            PG8_WAIT_V(8); PG8_WAIT_L(0); PG8_BAR; PG8_MMA(0, 0, At, B0); PG8_MMA(0, 1, At, B1); PG8_BAR; PG8_SCHED;
            PG8_LDA(At, 0, 1); PG8_STAGE(PG8_SB(0, 0), b2, voffB); PG8_STAGE(PG8_SB(0, 1), b2 + hstep, voffB); PG8_STAGE(PG8_SA(0, 0), a2, voffA);
            PG8_WAIT_V(8); PG8_WAIT_L(0); PG8_BAR; PG8_MMA(1, 0, At, B0); PG8_MMA(1, 1, At, B1); PG8_BAR; PG8_SCHED;
            PG8_LDB(B0, 1, 0); PG8_LDB(B1, 1, 1); PG8_SCHED; PG8_LDA(At, 1, 0); PG8_STAGE(PG8_SA(0, 1), a2 + hstep, voffA);
            PG8_WAIT_V(8); PG8_WAIT_L(0); PG8_BAR; PG8_MMA(0, 0, At, B0); PG8_MMA(0, 1, At, B1); PG8_BAR; PG8_SCHED;
            PG8_LDA(At, 1, 1); PG8_STAGE(PG8_SB(1, 0), b3, voffB); PG8_STAGE(PG8_SB(1, 1), b3 + hstep, voffB); PG8_STAGE(PG8_SA(1, 0), a3, voffA);
            PG8_WAIT_V(8); PG8_WAIT_L(0); PG8_BAR; PG8_MMA(1, 0, At, B0); PG8_MMA(1, 1, At, B1); PG8_BAR; PG8_SCHED;
            } else {
            PG8_LDB(B0, 0, 0); PG8_SCHED; PG8_LDA(At, 0, 0); PG8_STAGE(PG8_SA(1, 1), a1 + hstep, voffA);
            PG8_WAIT_L(8); PG8_BAR; PG8_WAIT_L(0); PG8_MMA(0, 0, At, B0); PG8_BAR; PG8_SCHED;
            PG8_LDB(B1, 0, 1); PG8_STAGE(PG8_SB(0, 0), b2, voffB);
            PG8_BAR; PG8_WAIT_L(0); PG8_MMA(0, 1, At, B1); PG8_BAR;
            PG8_LDA(At, 0, 1); PG8_STAGE(PG8_SA(0, 0), a2, voffA);
            PG8_BAR; PG8_WAIT_L(0); PG8_MMA(1, 0, At, B0); PG8_BAR; PG8_SCHED;
            PG8_STAGE(PG8_SB(0, 1), b2 + hstep, voffB);
            PG8_WAIT_V(6); PG8_BAR; PG8_MMA(1, 1, At, B1); PG8_BAR;
            PG8_LDB(B0, 1, 0); PG8_SCHED; PG8_LDA(At, 1, 0); PG8_STAGE(PG8_SA(0, 1), a2 + hstep, voffA);
            PG8_WAIT_L(8); PG8_BAR; PG8_WAIT_L(0); PG8_MMA(0, 0, At, B0); PG8_BAR; PG8_SCHED;
            PG8_LDB(B1, 1, 1); PG8_STAGE(PG8_SB(1, 0), b3, voffB);
            PG8_BAR; PG8_WAIT_L(0); PG8_MMA(0, 1, At, B1); PG8_BAR;
            PG8_LDA(At, 1, 1); PG8_STAGE(PG8_SA(1, 0), a3, voffA);
            PG8_BAR; PG8_WAIT_L(0); PG8_MMA(1, 0, At, B0); PG8_BAR; PG8_SCHED;
            PG8_STAGE(PG8_SB(1, 1), b3 + hstep, voffB);
            PG8_WAIT_V(6); PG8_BAR; PG8_MMA(1, 1, At, B1); PG8_BAR;
            }
        }
        if constexpr (ALIGN_EPI) { if (wr == 0) PG8_BAR; }
        if constexpr (!Epi::AFTER_DRAIN) { E(acc, cur, wr, wc, fr, fq); S.done(cur); }
        if (!has_next) break;
#pragma unroll
        for (int a = 0; a < 2; ++a)
#pragma unroll
            for (int b = 0; b < 2; ++b)
#pragma unroll
                for (int m = 0; m < 4; ++m)
#pragma unroll
                    for (int n = 0; n < 2; ++n) acc[a][b][m][n] = (f32x4){0.f, 0.f, 0.f, 0.f};
        cur = nxt; cA = nA; cB = nB; ++ui;
        if constexpr (ALIGN_EPI) { if (wr == 1) PG8_BAR; }
    }
    PG8_WAIT_V(0);
    if constexpr (!ALIGN_EPI) { if (wr == 0) PG8_BAR; }
    PG8_BAR;
    if constexpr (Epi::AFTER_DRAIN) { E.fused(acc, cur, wr, wc, fr, fq, lds, wid, lane); S.done(cur); }
#undef PG8_SA
#undef PG8_SB
#undef PG8_STAGE
#undef PG8_LDA
#undef PG8_LDB
#undef PG8_MMA
#undef PG8_WAIT_V
#undef PG8_WAIT_L
#undef PG8_BAR
#undef PG8_SCHED
}
}
#define GAS __attribute__((address_space(1)))
#define LAS __attribute__((address_space(3)))
typedef unsigned short bf16;
typedef unsigned v4u __attribute__((ext_vector_type(4)));
typedef float f32x4 __attribute__((ext_vector_type(4)));
typedef short bf16x8 __attribute__((ext_vector_type(8)));
typedef GAS unsigned gu32;
typedef GAS unsigned long long gu64;
#define RLX_AGENT __ATOMIC_RELAXED, __HIP_MEMORY_SCOPE_AGENT
#define LDS_WAIT() asm volatile("s_waitcnt lgkmcnt(0)" ::: "memory")
#define VM_WAIT() asm volatile("s_waitcnt vmcnt(0)" ::: "memory")
__device__ __forceinline__ unsigned long long rt() { return __builtin_amdgcn_s_memrealtime(); }
__device__ __forceinline__ unsigned f2bf(float f) { unsigned u = __builtin_bit_cast(unsigned, f); return (u + 0x7fffu + ((u >> 16) & 1u)) >> 16; }
__device__ __forceinline__ unsigned pk2(float lo, float hi) { return f2bf(lo) | (f2bf(hi) << 16); }

#define XB_TMO      128
#define XB_XCNT(j)  (256  + 64 * (j))
#define XB_XSUB(j)  (1280 + 64 * (j))
#define XB_XGEN(j)  (2304 + 64 * (j))
#define XB_TOP      3328
#define XB_TOPGEN   3392
#define XCD_BAR_WORDS 3456
#define XB_SPIN_CAP (1u << 18)

__device__ __forceinline__ unsigned xb_ld(unsigned* p)              { return __hip_atomic_load(p, __ATOMIC_RELAXED, __HIP_MEMORY_SCOPE_AGENT); }
__device__ __forceinline__ unsigned xb_add(unsigned* p, unsigned v) { return __hip_atomic_fetch_add(p, v, __ATOMIC_RELAXED, __HIP_MEMORY_SCOPE_AGENT); }
__device__ __forceinline__ unsigned xb_xcc_id() { return (unsigned)__builtin_amdgcn_s_getreg((3 << 11) | 20) & 0xFu; }
#define XB_SPIN(cond, bar) do { unsigned _sp = 0; while (cond) { __builtin_amdgcn_s_sleep(1); \
    if ((++_sp & 255u) == 0u) { if (xb_ld(&(bar)[XB_TMO])) break; if (_sp > XB_SPIN_CAP) { atomicAdd(&(bar)[XB_TMO], 1u); break; } } } } while (0)

struct XcdBarrier {
    unsigned* bar; unsigned x;
    volatile LAS unsigned* st;
};

__device__ __forceinline__ XcdBarrier xcd_barrier_post(unsigned* bar, volatile LAS unsigned* st) {
    XcdBarrier b; b.bar = bar; b.x = xb_xcc_id(); b.st = st;
    if (threadIdx.x == 0) (void)xb_add(&bar[XB_XCNT(b.x)], 1u);
    return b;
}
__device__ __forceinline__ void xcd_barrier_complete(unsigned* bar, unsigned x, unsigned& nloc, unsigned& nx) {
    const unsigned G = gridDim.x * gridDim.y * gridDim.z;
    unsigned sum, cnt, mine, sp = 0u;
    for (;;) {
        sum = 0u; cnt = 0u; mine = 0u;
#pragma unroll
        for (unsigned j = 0; j < 16; ++j) { const unsigned c = xb_ld(&bar[XB_XCNT(j)]); sum += c; cnt += (c > 0u) ? 1u : 0u; mine = (j == x) ? c : mine; }
        if (sum == G) break;
        __builtin_amdgcn_s_sleep(1);
        if ((++sp & 255u) == 0u) { if (xb_ld(&bar[XB_TMO])) break; if (sp > XB_SPIN_CAP) { atomicAdd(&bar[XB_TMO], 1u); break; } }
    }
    nloc = mine > 0u ? mine : 1u; nx = cnt > 0u ? cnt : 1u;
}

__device__ __forceinline__ void xcd_barrier(const XcdBarrier& b) {
    asm volatile("s_waitcnt vmcnt(0)" ::: "memory");
    __syncthreads();
    if (threadIdx.x == 0) {
        unsigned* bar = b.bar;
        __builtin_amdgcn_s_waitcnt(0);
        unsigned nloc = b.st[0], nx = b.st[1];
        if (nloc == 0u) { xcd_barrier_complete(bar, b.x, nloc, nx); b.st[0] = nloc; b.st[1] = nx; }
        const unsigned old = xb_add(&bar[XB_XSUB(b.x)], 1u);
        const unsigned gen = old / nloc;
        if (old + 1u == (gen + 1u) * nloc) {
            __builtin_amdgcn_fence(__ATOMIC_RELEASE, "agent");
            asm volatile("s_waitcnt vmcnt(0)" ::: "memory");
            const unsigned og = xb_add(&bar[XB_TOP], 1u);
            const unsigned tg = og / nx;
            if (og + 1u == (tg + 1u) * nx) xb_add(&bar[XB_TOPGEN], 1u);
            else XB_SPIN(xb_ld(&bar[XB_TOPGEN]) == tg, bar);
            __builtin_amdgcn_fence(__ATOMIC_ACQUIRE, "agent");
            xb_add(&bar[XB_XGEN(b.x)], 1u);
            asm volatile("s_waitcnt vmcnt(0)" ::: "memory");
        } else {
            XB_SPIN(xb_ld(&bar[XB_XGEN(b.x)]) == gen, bar);
            __builtin_amdgcn_fence(__ATOMIC_ACQUIRE, "agent");
            asm volatile("s_waitcnt vmcnt(0)" ::: "memory");
        }
    }
    __syncthreads();
}

constexpr int NWAVES = 8;
constexpr int SEQ = 16384, DM = 1024, DFF = 2816, DIN = 10768;
constexpr float EPS = 1e-6f;
constexpr float LOG2E = 1.4426950408889634f, LN2 = 0.6931471805599453f;
#ifndef MK_SPLIT
#define MK_SPLIT 0
#endif
constexpr int N_PHASES = 15;

constexpr size_t MiB = 1u << 20;
constexpr size_t WS_CTL = 0, CTL_ZERO_BYTES = 64 * 1024;
constexpr size_t WS_WIN = 2 * MiB;
constexpr size_t WS_WPA = 23 * MiB;
constexpr size_t WS_WPD = 24 * MiB;
constexpr size_t WS_WOUT = 26 * MiB;
constexpr size_t WS_WGU = 28 * MiB;
constexpr size_t WS_WDN = 39 * MiB;
constexpr size_t WS_BETA = 45 * MiB;
constexpr size_t WS_G = WS_BETA + MiB / 2;
constexpr size_t WS_LSE = 46 * MiB;
constexpr size_t WS_GC = 47 * MiB;
constexpr size_t WS_SSQ1 = 48 * MiB;
constexpr size_t WS_SSQ2 = 49 * MiB;
constexpr size_t WS_HALO = 50 * MiB;
constexpr size_t WS_U = 56 * MiB;
constexpr size_t WS_R = 88 * MiB;
constexpr size_t WS_QKVA = WS_R;
constexpr size_t WS_YA = 232 * MiB;
constexpr size_t WS_QKVD = WS_R;
constexpr size_t WS_TQ = 184 * MiB;
constexpr size_t WS_QK = 200 * MiB;
constexpr size_t WS_T1 = 88 * MiB;
constexpr size_t WS_T2 = 120 * MiB;
constexpr size_t WS_HB = 184 * MiB;
constexpr size_t WS_ACT = 88 * MiB;
constexpr size_t WS_END = 256 * MiB;
constexpr size_t DO_OG = 0, DO_Z = 0, DO_OD = 32 * MiB;
constexpr int CW_BAR = 4096;

constexpr int RING_OFF = 0, RING_BYTES = 147456;
constexpr int LDSCTL_OFF = RING_BYTES, MISC_OFF = LDSCTL_OFF + 320;
constexpr int LDS_BYTES = 151552;
static_assert(MISC_OFF + 128 <= LDS_BYTES, "LDS map");

typedef unsigned u32x2 __attribute__((ext_vector_type(2)));
typedef short v4i16_t __attribute__((ext_vector_type(4)));
#define MFMA16(a, b, c) __builtin_amdgcn_mfma_f32_16x16x32_bf16((a), (b), (c), 0, 0, 0)
typedef float f32x2_t __attribute__((ext_vector_type(2))); typedef __bf16 bf16x2_t __attribute__((ext_vector_type(2)));
__device__ __forceinline__ unsigned cvtpk(float lo, float hi) { f32x2_t v = {lo, hi}; bf16x2_t b = __builtin_convertvector(v, bf16x2_t); return __builtin_bit_cast(unsigned, b); }
__device__ __forceinline__ bf16x8 pack8f(const f32x4 a, const f32x4 b) { v4u w; w.x = cvtpk(a[0], a[1]); w.y = cvtpk(a[2], a[3]); w.z = cvtpk(b[0], b[1]); w.w = cvtpk(b[2], b[3]); return __builtin_bit_cast(bf16x8, w); }
__device__ __forceinline__ float bflo(unsigned w) { return __uint_as_float(w << 16); }
__device__ __forceinline__ float bfhi(unsigned w) { return __uint_as_float(w & 0xffff0000u); }
__device__ __forceinline__ u32x2 tr16(const LAS unsigned char* p) { return __builtin_bit_cast(u32x2, __builtin_amdgcn_ds_read_tr16_b64_v4i16((LAS v4i16_t*)p)); }
__device__ __forceinline__ bf16x8 cat8(u32x2 lo, u32x2 hi) { v4u w; w.x = lo.x; w.y = lo.y; w.z = hi.x; w.w = hi.y; return __builtin_bit_cast(bf16x8, w); }
__device__ __forceinline__ float wave_sum(float v) {
#pragma unroll
    for (int o = 1; o < 64; o <<= 1) v += __shfl_xor(v, o);
    return v;
}

struct Frame {
    LAS unsigned char* lds;
    volatile LAS unsigned* MISC;
    gu32* ctl;
    int tid, lane, wave;
    int vcu, G;
    const float *x, *norm_mix, *w_in, *conv_w, *a_log, *dt_bias, *dn_norm, *w_pa, *w_pd, *w_out, *norm_ffn, *w_gate, *w_up, *w_down, *norm_final;
    float* out; unsigned char* ws;
};

__device__ __forceinline__ void tr_item(const float* W, int ldw, int k0, int nsrc, bf16* WT, int Kd, int drow, const float* kscale, LAS float* scr, int lane) {
#pragma unroll 8
    for (int i = 0; i < 32; ++i) { const int kk = 2 * i + (lane >> 5); float v = W[(size_t)(k0 + kk) * ldw + nsrc + (lane & 31)]; if (kscale) v *= kscale[k0 + kk]; scr[kk * 33 + (lane & 31)] = v; }
    LDS_WAIT(); asm volatile("" ::: "memory");
    const int c = lane & 7;
#pragma unroll
    for (int j = 0; j < 4; ++j) { const int n = (lane >> 3) + 8 * j; const LAS float* s = scr + (8 * c) * 33 + n;
        v4u o; o.x = pk2(s[0 * 33], s[1 * 33]); o.y = pk2(s[2 * 33], s[3 * 33]); o.z = pk2(s[4 * 33], s[5 * 33]); o.w = pk2(s[6 * 33], s[7 * 33]);
        *(GAS v4u*)(WT + (size_t)(drow + n) * Kd + k0 + 8 * c) = o; }
    LDS_WAIT(); asm volatile("" ::: "memory");
}
__device__ __forceinline__ void p0_prologue(Frame& F) {
    LAS float* scr = (LAS float*)(F.lds + RING_OFF + F.wave * 16384);
    const int gw = F.vcu * NWAVES + F.wave, NGW = F.G * NWAVES;
    bf16* WIN = (bf16*)(F.ws + WS_WIN); bf16* WPA = (bf16*)(F.ws + WS_WPA); bf16* WPD = (bf16*)(F.ws + WS_WPD); bf16* WOUT = (bf16*)(F.ws + WS_WOUT);
    bf16* WGU = (bf16*)(F.ws + WS_WGU); bf16* WDN = (bf16*)(F.ws + WS_WDN);
    constexpr int I0 = 16 * 272, I1 = 16 * 64, I2 = 8 * 32, I3 = 16 * 32, I4 = 16 * 32, I5 = 16 * 88, I6 = 16 * 88, I7 = 44 * 32;
    constexpr int NITEMS = I0 + I1 + I2 + I3 + I4 + I5 + I6 + I7;
    for (int it = gw; it < NITEMS; it += NGW) {
        int r = it;
        if (r < I0) { const int kb = r / 272, nb = r % 272; tr_item(F.w_in, DIN, 64 * kb, 32 * nb, WIN, 1024, 32 * nb, nullptr, scr, F.lane); continue; } r -= I0;
        if (r < I1) { const int kb = r / 64, nb = r % 64, j0 = 32 * nb, which = j0 >> 10, jj = j0 & 1023;
            tr_item(F.w_in, DIN, 64 * kb, 8720 + j0, WIN, 1024, 8704 + 256 * (jj >> 7) + 128 * which + (jj & 127), nullptr, scr, F.lane); continue; } r -= I1;
        if (r < I2) { const int kb = r / 32, nb = r % 32; tr_item(F.w_pa, 1024, 64 * kb, 32 * nb, WPA, 512, 32 * nb, nullptr, scr, F.lane); continue; } r -= I2;
        if (r < I3) { const int kb = r / 32, nb = r % 32; tr_item(F.w_pd, 1024, 64 * kb, 32 * nb, WPD, 1024, 32 * nb, nullptr, scr, F.lane); continue; } r -= I3;
        if (r < I4) { const int kb = r / 32, nb = r % 32; tr_item(F.w_out, 1024, 64 * kb, 32 * nb, WOUT, 1024, 32 * nb, nullptr, scr, F.lane); continue; } r -= I4;
        if (r < I5) { const int kb = r / 88, nb = r % 88, j0 = 32 * nb; tr_item(F.w_gate, DFF, 64 * kb, j0, WGU, 1024, 256 * (j0 >> 7) + (j0 & 127), F.norm_ffn, scr, F.lane); continue; } r -= I5;
        if (r < I6) { const int kb = r / 88, nb = r % 88, j0 = 32 * nb; tr_item(F.w_up, DFF, 64 * kb, j0, WGU, 1024, 256 * (j0 >> 7) + 128 + (j0 & 127), F.norm_ffn, scr, F.lane); continue; } r -= I6;
        { const int kb = r / 32, nb = r % 32; tr_item(F.w_down, 1024, 64 * kb, 32 * nb, WDN, DFF, 32 * nb, nullptr, scr, F.lane); }
    }
    __syncthreads();
    LAS float* wba = (LAS float*)(F.lds + RING_OFF);
    for (int idx = F.tid; idx < 16384; idx += NWAVES * 64) { const int k = idx >> 4, c = idx & 15; const int ln = (k & 255) >> 2, i = k & 3, j = k >> 8;
        wba[((((j * 4 + i) * 4 + (c >> 2)) * 64 + ln) << 2) + (c & 3)] = F.w_in[(size_t)k * DIN + 8704 + c]; }
    __syncthreads();
    bf16* U = (bf16*)(F.ws + WS_U); float* BETA = (float*)(F.ws + WS_BETA); float* GG = (float*)(F.ws + WS_G);
    for (int m = gw; m < SEQ; m += NGW) {
        asm volatile("" ::: "memory");
        const GAS f32x4* xr = (const GAS f32x4*)(F.x + (size_t)m * DM) + F.lane;
        f32x4 v[4]; float s = 0.f;
#pragma unroll
        for (int j = 0; j < 4; ++j) { v[j] = xr[64 * j]; s += (v[j].x * v[j].x + v[j].y * v[j].y) + (v[j].z * v[j].z + v[j].w * v[j].w); }
        const float rstd = 1.0f / sqrtf(wave_sum(s) * (1.f / DM) + EPS);
        GAS unsigned long long* o8 = (GAS unsigned long long*)(U + (size_t)m * DM) + F.lane;
        float acc[16];
#pragma unroll
        for (int c = 0; c < 16; ++c) acc[c] = 0.f;
#pragma unroll
        for (int j = 0; j < 4; ++j) { const f32x4 nm = ((const GAS f32x4*)F.norm_mix)[F.lane + 64 * j]; v[j] = v[j] * rstd * nm;
            o8[64 * j] = (unsigned long long)cvtpk(v[j].x, v[j].y) | ((unsigned long long)cvtpk(v[j].z, v[j].w) << 32);
#pragma unroll
            for (int i = 0; i < 4; ++i)
#pragma unroll
                for (int c4 = 0; c4 < 4; ++c4) { const f32x4 w = *(const LAS f32x4*)(wba + ((((j * 4 + i) * 4 + c4) * 64 + F.lane) << 2));
                    acc[4 * c4 + 0] += v[j][i] * w[0]; acc[4 * c4 + 1] += v[j][i] * w[1]; acc[4 * c4 + 2] += v[j][i] * w[2]; acc[4 * c4 + 3] += v[j][i] * w[3]; } }
        float mine = 0.f;
#pragma unroll
        for (int c = 0; c < 16; ++c) { const float t = wave_sum(acc[c]); mine = (F.lane == c) ? t : mine; }
        if (F.lane < 8) BETA[(size_t)m * 8 + F.lane] = 1.0f / (1.0f + expf(-mine));
        else if (F.lane < 16) { const int hh = F.lane - 8; const float xx = mine + F.dt_bias[hh]; const float sp = fmaxf(xx, 0.f) + log1pf(expf(-fabsf(xx))); GG[(size_t)m * 8 + hh] = -expf(F.a_log[hh]) * sp; }
    }
}

__device__ __forceinline__ void attn_phase(Frame& F) {
    const bf16* QKV = (const bf16*)(F.ws + WS_QKVA);
    bf16* OG = (bf16*)((unsigned char*)F.out + DO_OG); float* LSE = (float*)(F.ws + WS_LSE);
    LAS unsigned char* Ks = F.lds + RING_OFF; LAS unsigned char* Vs = Ks + 256 * 272;
    const int lane = F.lane, w = F.wave, l15 = lane & 15, q4 = lane >> 4;
    for (int unit = F.vcu; unit < 12 * 128; unit += F.G) {
        const int h = unit >> 7, tau = unit & 127, gi = h >> 2, hh = h & 3, sh = 2 * gi, d = 1 << sh, r = tau & (d - 1), n = tau >> sh;
        { const int key = F.tid >> 1, half = F.tid & 1; const int sidx = (n - 1) * 128 + key;
            v4u kv[8], vv[8];
            if (sidx >= 0) { const size_t pos = (size_t)sidx * d + r;
                const GAS v4u* kp = (const GAS v4u*)(QKV + pos * 4608 + 1536 + h * 128 + half * 64); const GAS v4u* vp = (const GAS v4u*)(QKV + pos * 4608 + 3072 + h * 128 + half * 64);
#pragma unroll
                for (int i = 0; i < 8; ++i) { kv[i] = kp[i]; vv[i] = vp[i]; } }
            else {
#pragma unroll
                for (int i = 0; i < 8; ++i) { kv[i] = (v4u){0u, 0u, 0u, 0u}; vv[i] = (v4u){0u, 0u, 0u, 0u}; } }
#pragma unroll
            for (int i = 0; i < 8; ++i) { *(LAS v4u*)(Ks + key * 272 + half * 128 + i * 16) = kv[i]; *(LAS v4u*)(Vs + key * 288 + half * 128 + i * 16) = vv[i]; } }
        const int iq = 16 * w + l15; const size_t posq = (size_t)(n * 128 + iq) * d + r;
        bf16x8 qf[4];
#pragma unroll
        for (int ks = 0; ks < 4; ++ks) qf[ks] = *(const GAS bf16x8*)(QKV + posq * 4608 + h * 128 + 32 * ks + 8 * q4);
        __syncthreads();
        f32x4 sacc[9];
#pragma unroll
        for (int t = 0; t < 9; ++t) { sacc[t] = (f32x4){0.f, 0.f, 0.f, 0.f}; const LAS unsigned char* kp = Ks + (16 * (w + t) + l15) * 272 + 16 * q4;
#pragma unroll
            for (int ks = 0; ks < 4; ++ks) { const bf16x8 a = *(const LAS bf16x8*)(kp + 64 * ks); sacc[t] = MFMA16(a, qf[ks], sacc[t]); } }
        const float slope = exp2f(-8.0f * (float)(h + 1) / 12.0f);
        const float c1 = 0.08838834764831845f * LOG2E, c2 = slope * (float)d * LOG2E;
        float mx = -INFINITY;
#pragma unroll
        for (int t = 0; t < 9; ++t)
#pragma unroll
            for (int rg = 0; rg < 4; ++rg) { const int delta = 128 + l15 - 16 * t - 4 * q4 - rg; const int j = 16 * (w + t) + 4 * q4 + rg;
                const bool valid = (delta >= 0) && (delta <= 128) && (n > 0 || j >= 128);
                const float s = valid ? (sacc[t][rg] * c1 - c2 * (float)delta) : -INFINITY; sacc[t][rg] = s; mx = fmaxf(mx, s); }
        mx = fmaxf(mx, __shfl_xor(mx, 16)); mx = fmaxf(mx, __shfl_xor(mx, 32));
        float den = 0.f;
#pragma unroll
        for (int t = 0; t < 9; ++t)
#pragma unroll
            for (int rg = 0; rg < 4; ++rg) { const float p = exp2f(sacc[t][rg] - mx); den += p; sacc[t][rg] = p; }
        den += __shfl_xor(den, 16); den += __shfl_xor(den, 32);
        f32x4 oacc[8];
#pragma unroll
        for (int mt = 0; mt < 8; ++mt) oacc[mt] = (f32x4){0.f, 0.f, 0.f, 0.f};
#pragma unroll
        for (int u = 0; u < 5; ++u) { const bf16x8 pk = pack8f(sacc[2 * u], (u < 4) ? sacc[(u < 4) ? 2 * u + 1 : 0] : (f32x4){0.f, 0.f, 0.f, 0.f});
            const int kt0 = w + 2 * u, kt1 = (w + 2 * u + 1 < 16) ? w + 2 * u + 1 : 15;
            const LAS unsigned char* v0p = Vs + (16 * kt0 + 4 * q4 + (l15 >> 2)) * 288 + 8 * (l15 & 3); const LAS unsigned char* v1p = Vs + (16 * kt1 + 4 * q4 + (l15 >> 2)) * 288 + 8 * (l15 & 3);
#pragma unroll
            for (int mt = 0; mt < 8; ++mt) { const bf16x8 a = cat8(tr16(v0p + 32 * mt), tr16(v1p + 32 * mt)); oacc[mt] = MFMA16(a, pk, oacc[mt]); } }
        const float inv = 1.0f / den;
        bf16* op = OG + ((size_t)gi * SEQ + posq) * 512 + hh * 128 + 4 * q4;
#pragma unroll
        for (int mt = 0; mt < 8; ++mt) { u32x2 wv; wv.x = cvtpk(oacc[mt][0] * inv, oacc[mt][1] * inv); wv.y = cvtpk(oacc[mt][2] * inv, oacc[mt][3] * inv); *(GAS u32x2*)(op + 16 * mt) = wv; }
        if (q4 == 0) LSE[((size_t)gi * SEQ + posq) * 4 + hh] = (mx + log2f(den)) * LN2;
        __syncthreads();
    }
}

__device__ __forceinline__ void merge_phase(Frame& F) {
    const bf16* OG = (const bf16*)((unsigned char*)F.out + DO_OG); const float* LSE = (const float*)(F.ws + WS_LSE); bf16* YA = (bf16*)(F.ws + WS_YA);
    const int gw = F.vcu * NWAVES + F.wave, NGW = F.G * NWAVES, hh = F.lane >> 4;
    for (int p = gw; p < SEQ; p += NGW) {
        const float l0 = LSE[((size_t)0 * SEQ + p) * 4 + hh], l1 = LSE[((size_t)1 * SEQ + p) * 4 + hh], l2 = LSE[((size_t)2 * SEQ + p) * 4 + hh];
        const float m = fmaxf(l0, fmaxf(l1, l2)); float w0 = expf(l0 - m), w1 = expf(l1 - m), w2 = expf(l2 - m); const float inv = 1.0f / (w0 + w1 + w2); w0 *= inv; w1 *= inv; w2 *= inv;
        const v4u a = *(const GAS v4u*)(OG + ((size_t)0 * SEQ + p) * 512 + F.lane * 8), b = *(const GAS v4u*)(OG + ((size_t)1 * SEQ + p) * 512 + F.lane * 8), c = *(const GAS v4u*)(OG + ((size_t)2 * SEQ + p) * 512 + F.lane * 8);
        v4u o;
#pragma unroll
        for (int i = 0; i < 4; ++i) o[i] = cvtpk(w0 * bflo(a[i]) + w1 * bflo(b[i]) + w2 * bflo(c[i]), w0 * bfhi(a[i]) + w1 * bfhi(b[i]) + w2 * bfhi(c[i]));
        *(GAS v4u*)(YA + (size_t)p * 512 + F.lane * 8) = o;
    }
}

__device__ __forceinline__ void prep_phase(Frame& F) {
    bf16* QKVD = (bf16*)(F.ws + WS_QKVD); const bf16* HALO = (const bf16*)(F.ws + WS_HALO);
    const float* BETA = (const float*)(F.ws + WS_BETA); const float* GG = (const float*)(F.ws + WS_G); float* GC = (float*)(F.ws + WS_GC);
    bf16* TQ = (bf16*)(F.ws + WS_TQ); bf16* QK = (bf16*)(F.ws + WS_QK);
    const int gw = F.vcu * NWAVES + F.wave, NGW = F.G * NWAVES, lane = F.lane, l15 = lane & 15, q4 = lane >> 4;
    LAS float* A = (LAS float*)(F.lds + RING_OFF + F.wave * 16896); LAS float* gcs = A + 4096; LAS float* bts = gcs + 64;
    for (int task = gw; task < 2048; task += NGW) {
        const int n = task >> 3, h = task & 7;
        { float gv = GG[(size_t)(64 * n + lane) * 8 + h];
#pragma unroll
            for (int off = 1; off < 64; off <<= 1) { const float t = __shfl_up(gv, off); if (lane >= off) gv += t; }
            gcs[lane] = gv; bts[lane] = BETA[(size_t)(64 * n + lane) * 8 + h]; GC[(size_t)task * 64 + lane] = gv; }
#pragma unroll 1
        for (int sg = 0; sg < 3; ++sg) {
            const int col = sg * 1024 + h * 128 + 2 * lane;
            float wa[4], wb[4];
#pragma unroll
            for (int j = 0; j < 4; ++j) { wa[j] = F.conv_w[(size_t)j * 3072 + col]; wb[j] = F.conv_w[(size_t)j * 3072 + col + 1]; }
            float pa0 = 0.f, pb0 = 0.f, pa1 = 0.f, pb1 = 0.f, pa2 = 0.f, pb2 = 0.f;
            if (n > 0) { const bf16* hp = HALO + (size_t)(n - 1) * 3 * 3072 + col;
                const unsigned h0 = *(const GAS unsigned*)(hp), h1 = *(const GAS unsigned*)(hp + 3072), h2 = *(const GAS unsigned*)(hp + 2 * 3072);
                pa0 = bflo(h0); pb0 = bfhi(h0); pa1 = bflo(h1); pb1 = bfhi(h1); pa2 = bflo(h2); pb2 = bfhi(h2); }
            bf16* base = QKVD + (size_t)(64 * n) * 3072 + col;
            const float sc = (sg == 0) ? 0.08838834764831845f : 1.0f;
#pragma unroll 4
            for (int t = 0; t < 64; ++t) {
                const unsigned xv = *(const GAS unsigned*)(base + (size_t)t * 3072);
                const float xa = bflo(xv), xb = bfhi(xv);
                float ya = wa[0] * pa0 + wa[1] * pa1 + wa[2] * pa2 + wa[3] * xa, yb = wb[0] * pb0 + wb[1] * pb1 + wb[2] * pb2 + wb[3] * xb;
                ya = ya / (1.0f + __expf(-ya)); yb = yb / (1.0f + __expf(-yb));
                if (sg != 2) { const float ss = wave_sum(ya * ya + yb * yb); const float rs = sc / sqrtf(ss + EPS); ya *= rs; yb *= rs; }
                *(GAS unsigned*)(base + (size_t)t * 3072) = cvtpk(ya, yb);
                pa0 = pa1; pb0 = pb1; pa1 = pa2; pb1 = pb2; pa2 = xa; pb2 = xb; } }
        asm volatile("s_waitcnt vmcnt(0) lgkmcnt(0)" ::: "memory");
        bf16x8 kf[4][4];
        const bf16* rp0 = QKVD + (size_t)(64 * n + l15) * 3072 + h * 128 + 8 * q4;
#pragma unroll
        for (int mt = 0; mt < 4; ++mt)
#pragma unroll
            for (int ks = 0; ks < 4; ++ks) kf[mt][ks] = *(const GAS bf16x8*)(rp0 + (size_t)mt * (16 * 3072) + 1024 + 32 * ks);
        bf16* qkb = QK + (size_t)task * 4096 + (4 * q4) * 64 + l15;
        LAS float* Ab = A + (4 * q4) * 64 + l15;
#pragma unroll
        for (int mt = 0; mt < 4; ++mt) { const f32x4 gi4 = *(const LAS f32x4*)(gcs + 16 * mt + 4 * q4), bi4 = *(const LAS f32x4*)(bts + 16 * mt + 4 * q4);
            bf16x8 qf[4];
#pragma unroll
            for (int ks = 0; ks < 4; ++ks) qf[ks] = *(const GAS bf16x8*)(rp0 + (size_t)mt * (16 * 3072) + 32 * ks);
#pragma unroll
            for (int nt = 0; nt < 4; ++nt) {
                if (nt <= mt) { const float gj = gcs[16 * nt + l15];
                    f32x4 akk = (f32x4){0.f, 0.f, 0.f, 0.f}, aqk = (f32x4){0.f, 0.f, 0.f, 0.f};
#pragma unroll
                    for (int ks = 0; ks < 4; ++ks) { akk = MFMA16(kf[mt][ks], kf[nt][ks], akk); aqk = MFMA16(qf[ks], kf[nt][ks], aqk); }
#pragma unroll
                    for (int rg = 0; rg < 4; ++rg) { const int i = 16 * mt + 4 * q4 + rg, j = 16 * nt + l15; const float dec = __expf(fminf(gi4[rg] - gj, 0.f));
                        Ab[(16 * mt + rg) * 64 + 16 * nt] = (i > j) ? bi4[rg] * akk[rg] * dec : 0.f;
                        qkb[(16 * mt + rg) * 64 + 16 * nt] = (bf16)f2bf((i >= j) ? aqk[rg] * dec : 0.f); }
                } else {
#pragma unroll
                    for (int rg = 0; rg < 4; ++rg) { Ab[(16 * mt + rg) * 64 + 16 * nt] = 0.f; qkb[(16 * mt + rg) * 64 + 16 * nt] = (bf16)0; }
                } }
            asm volatile("" ::: "memory"); }
        LDS_WAIT(); asm volatile("" ::: "memory");
        bf16* tg = TQ + (size_t)task * 4096 + lane;
#pragma unroll 1
        for (int i = 0; i < 64; ++i) { float s = (i == lane) ? 1.f : 0.f;
#pragma unroll 2
            for (int j4 = 0; j4 < i; j4 += 4) { const f32x4 a = *(const LAS f32x4*)(A + i * 64 + j4);
                const float t0 = A[(j4 + 0) * 64 + lane], t1 = A[(j4 + 1) * 64 + lane], t2 = A[(j4 + 2) * 64 + lane], t3 = A[(j4 + 3) * 64 + lane];
                s -= a[0] * t0; s -= a[1] * t1; s -= a[2] * t2; s -= a[3] * t3; }
            A[i * 64 + lane] = s; tg[i * 64] = (bf16)f2bf(s); }
        LDS_WAIT(); asm volatile("" ::: "memory");
    }
}

constexpr int SC_K = 0, SC_Q = 17408, SC_V = 34816, SC_T = 52224, SC_QK = 61440, SC_GC = 70656, SC_BT = 70912, SC_BUF = 71168;
static_assert(2 * SC_BUF <= RING_BYTES, "scan LDS");
constexpr int SCAN_BLOCKS = 16;
__device__ __forceinline__ bf16x8 ld2x64(const LAS unsigned char* p) { const u32x2 a = *(const LAS u32x2*)p, b = *(const LAS u32x2*)(p + 32); return cat8(a, b); }
__device__ __forceinline__ void scan_phase(Frame& F) {
    if (F.vcu >= SCAN_BLOCKS) return;
    const bf16* QKVD = (const bf16*)(F.ws + WS_QKVD); const bf16* TQ = (const bf16*)(F.ws + WS_TQ); const bf16* QK = (const bf16*)(F.ws + WS_QK);
    const float* GC = (const float*)(F.ws + WS_GC); const float* BETA = (const float*)(F.ws + WS_BETA);
    bf16* OD = (bf16*)((unsigned char*)F.out + DO_OD);
    const int head = F.vcu >> 1, tid = F.tid, lane = F.lane, w = F.wave, l15 = lane & 15, q4 = lane >> 4;
    const int v0 = 16 * (4 * (F.vcu & 1) + (w & 3));
    LAS unsigned char* L = F.lds + RING_OFF;
    v4u rk[2], rq[2], rv[2], rt, rqk; float rs = 0.f;
#define SC_LOAD(n_) do { const int task_ = (n_) * 8 + head; \
        _Pragma("unroll") for (int i_ = 0; i_ < 2; ++i_) { const int id_ = tid + 512 * i_, row_ = id_ >> 4, pc_ = id_ & 15; const bf16* src_ = QKVD + (size_t)(64 * (n_) + row_) * 3072 + head * 128 + pc_ * 8; \
            rq[i_] = *(const GAS v4u*)(src_); rk[i_] = *(const GAS v4u*)(src_ + 1024); rv[i_] = *(const GAS v4u*)(src_ + 2048); } \
        rt = *(const GAS v4u*)(TQ + (size_t)task_ * 4096 + tid * 8); rqk = *(const GAS v4u*)(QK + (size_t)task_ * 4096 + tid * 8); \
        if (tid < 64) rs = GC[(size_t)task_ * 64 + tid]; else if (tid < 128) rs = BETA[(size_t)(64 * (n_) + tid - 64) * 8 + head]; } while (0)
#define SC_WRITE(b_) do { LAS unsigned char* B_ = L + (b_) * SC_BUF; \
        _Pragma("unroll") for (int i_ = 0; i_ < 2; ++i_) { const int id_ = tid + 512 * i_, row_ = id_ >> 4, pc_ = id_ & 15; \
            *(LAS v4u*)(B_ + SC_Q + row_ * 272 + pc_ * 16) = rq[i_]; *(LAS v4u*)(B_ + SC_K + row_ * 272 + pc_ * 16) = rk[i_]; *(LAS v4u*)(B_ + SC_V + row_ * 272 + pc_ * 16) = rv[i_]; } \
        *(LAS v4u*)(B_ + SC_T + (tid >> 3) * 144 + (tid & 7) * 16) = rt; *(LAS v4u*)(B_ + SC_QK + (tid >> 3) * 144 + (tid & 7) * 16) = rqk; \
        if (tid < 64) *(LAS float*)(B_ + SC_GC + tid * 4) = rs; else if (tid < 128) *(LAS float*)(B_ + SC_BT + (tid - 64) * 4) = rs; } while (0)
    SC_LOAD(0); SC_WRITE(0); __syncthreads();
    f32x4 S[8];
#pragma unroll
    for (int dt = 0; dt < 8; ++dt) S[dt] = (f32x4){0.f, 0.f, 0.f, 0.f};
    for (int n = 0; n < 256; ++n) {
        if (n + 1 < 256) SC_LOAD(n + 1);
        if (w < 4) {
            const LAS unsigned char* B = L + (n & 1) * SC_BUF;
            bf16x8 SB[4];
#pragma unroll
            for (int s = 0; s < 4; ++s) SB[s] = pack8f(S[2 * s], S[2 * s + 1]);
            f32x4 kS[4], qS[4];
#pragma unroll
            for (int mt = 0; mt < 4; ++mt) { kS[mt] = (f32x4){0.f, 0.f, 0.f, 0.f}; qS[mt] = (f32x4){0.f, 0.f, 0.f, 0.f};
#pragma unroll
                for (int s = 0; s < 4; ++s) { kS[mt] = MFMA16(ld2x64(B + SC_K + (16 * mt + l15) * 272 + 64 * s + 8 * q4), SB[s], kS[mt]);
                    qS[mt] = MFMA16(ld2x64(B + SC_Q + (16 * mt + l15) * 272 + 64 * s + 8 * q4), SB[s], qS[mt]); } }
            const float gl = *(const LAS float*)(B + SC_GC + 63 * 4);
            f32x4 rhs[4], egc[4], edl[4];
#pragma unroll
            for (int mt = 0; mt < 4; ++mt) { const f32x4 g4 = *(const LAS f32x4*)(B + SC_GC + (16 * mt + 4 * q4) * 4), b4 = *(const LAS f32x4*)(B + SC_BT + (16 * mt + 4 * q4) * 4);
#pragma unroll
                for (int rg = 0; rg < 4; ++rg) { egc[mt][rg] = __expf(g4[rg]); edl[mt][rg] = __expf(gl - g4[rg]);
                    const float vv = __uint_as_float((unsigned)(*(const LAS unsigned short*)(B + SC_V + (16 * mt + 4 * q4 + rg) * 272 + (v0 + l15) * 2)) << 16);
                    rhs[mt][rg] = b4[rg] * (vv - egc[mt][rg] * kS[mt][rg]); } }
            bf16x8 RB[2]; RB[0] = pack8f(rhs[0], rhs[1]); RB[1] = pack8f(rhs[2], rhs[3]);
            f32x4 uu[4];
#pragma unroll
            for (int mt = 0; mt < 4; ++mt) { uu[mt] = (f32x4){0.f, 0.f, 0.f, 0.f};
#pragma unroll
                for (int s = 0; s < 2; ++s) if (s <= (mt >> 1)) uu[mt] = MFMA16(ld2x64(B + SC_T + (16 * mt + l15) * 144 + 64 * s + 8 * q4), RB[s], uu[mt]); }
            bf16x8 UB[2]; UB[0] = pack8f(uu[0], uu[1]); UB[1] = pack8f(uu[2], uu[3]);
#pragma unroll
            for (int mt = 0; mt < 4; ++mt) { f32x4 o = egc[mt] * qS[mt];
#pragma unroll
                for (int s = 0; s < 2; ++s) if (s <= (mt >> 1)) o = MFMA16(ld2x64(B + SC_QK + (16 * mt + l15) * 144 + 64 * s + 8 * q4), UB[s], o);
#pragma unroll
                for (int rg = 0; rg < 4; ++rg) OD[(size_t)(64 * n + 16 * mt + 4 * q4 + rg) * 1024 + head * 128 + v0 + l15] = (bf16)f2bf(o[rg]); }
            bf16x8 DB[2]; DB[0] = pack8f(uu[0] * edl[0], uu[1] * edl[1]); DB[1] = pack8f(uu[2] * edl[2], uu[3] * edl[3]);
            const float egl = __expf(gl);
#pragma unroll
            for (int dt = 0; dt < 8; ++dt) { S[dt] = S[dt] * egl;
#pragma unroll
                for (int s = 0; s < 2; ++s) { const LAS unsigned char* kp = B + SC_K + (32 * s + 4 * q4 + (l15 >> 2)) * 272 + (16 * dt + 4 * (l15 & 3)) * 2;
                    S[dt] = MFMA16(cat8(tr16(kp), tr16(kp + 16 * 272)), DB[s], S[dt]); } }
        }
        if (n + 1 < 256) SC_WRITE((n + 1) & 1);
        __syncthreads();
    }
#undef SC_LOAD
#undef SC_WRITE
}

__device__ __forceinline__ void finalize_delta_phase(Frame& F) {
    bf16* OD = (bf16*)((unsigned char*)F.out + DO_OD); const bf16* Z = (const bf16*)((unsigned char*)F.out + DO_Z);
    const int gw = F.vcu * NWAVES + F.wave, NGW = F.G * NWAVES, lane = F.lane;
    const int dc = (lane & 7) * 16;
    f32x4 dn[4];
#pragma unroll
    for (int i = 0; i < 4; ++i) dn[i] = *(const GAS f32x4*)(F.dn_norm + dc + 4 * i);
    for (int row = gw; row < SEQ; row += NGW) {
        const v4u o0 = *(const GAS v4u*)(OD + (size_t)row * 1024 + lane * 16), o1 = *(const GAS v4u*)(OD + (size_t)row * 1024 + lane * 16 + 8);
        const v4u z0 = *(const GAS v4u*)(Z + (size_t)row * 1024 + lane * 16), z1 = *(const GAS v4u*)(Z + (size_t)row * 1024 + lane * 16 + 8);
        float o[16], z[16];
#pragma unroll
        for (int i = 0; i < 4; ++i) { o[2 * i] = bflo(o0[i]); o[2 * i + 1] = bfhi(o0[i]); o[8 + 2 * i] = bflo(o1[i]); o[8 + 2 * i + 1] = bfhi(o1[i]);
            z[2 * i] = bflo(z0[i]); z[2 * i + 1] = bfhi(z0[i]); z[8 + 2 * i] = bflo(z1[i]); z[8 + 2 * i + 1] = bfhi(z1[i]); }
        float ss = 0.f;
#pragma unroll
        for (int i = 0; i < 16; ++i) ss += o[i] * o[i];
        ss += __shfl_xor(ss, 1); ss += __shfl_xor(ss, 2); ss += __shfl_xor(ss, 4);
        const float rs = 1.0f / sqrtf(ss * (1.0f / 128.0f) + EPS);
        v4u w0, w1;
#pragma unroll
        for (int i = 0; i < 4; ++i) { w0[i] = cvtpk(o[2 * i] * rs * dn[i >> 1][(2 * i) & 3] * z[2 * i], o[2 * i + 1] * rs * dn[i >> 1][(2 * i + 1) & 3] * z[2 * i + 1]);
            w1[i] = cvtpk(o[8 + 2 * i] * rs * dn[2 + (i >> 1)][(2 * i) & 3] * z[8 + 2 * i], o[8 + 2 * i + 1] * rs * dn[2 + (i >> 1)][(2 * i + 1) & 3] * z[8 + 2 * i + 1]); }
        *(GAS v4u*)(OD + (size_t)row * 1024 + lane * 16) = w0; *(GAS v4u*)(OD + (size_t)row * 1024 + lane * 16 + 8) = w1;
    }
}

__device__ __forceinline__ void final_norm_phase(Frame& F) {
    const float* SSQ = (const float*)(F.ws + WS_SSQ2);
    const int gw = F.vcu * NWAVES + F.wave, NGW = F.G * NWAVES, lane = F.lane;
    f32x4 nf[4];
#pragma unroll
    for (int j = 0; j < 4; ++j) nf[j] = ((const GAS f32x4*)F.norm_final)[lane + 64 * j];
    for (int row = gw; row < SEQ; row += NGW) {
        const f32x4* sp = (const f32x4*)(SSQ + (size_t)row * 16); const f32x4 s0 = sp[0], s1 = sp[1], s2 = sp[2], s3 = sp[3];
        const float ss = ((s0[0] + s0[1]) + (s0[2] + s0[3])) + ((s1[0] + s1[1]) + (s1[2] + s1[3])) + ((s2[0] + s2[1]) + (s2[2] + s2[3])) + ((s3[0] + s3[1]) + (s3[2] + s3[3]));
        const float rs = 1.0f / sqrtf(ss * (1.0f / 1024.0f) + EPS);
        GAS f32x4* hr = (GAS f32x4*)(F.out + (size_t)row * DM) + lane;
#pragma unroll
        for (int j = 0; j < 4; ++j) { const f32x4 v = hr[64 * j]; hr[64 * j] = v * rs * nf[j]; }
    }
}

struct Args { const float* in[15]; float* out; unsigned char* ws; int ph_lo, ph_hi; };
__global__ void __launch_bounds__(NWAVES * 64, 2) hyb_fwd(Args args) {
    extern __shared__ __attribute__((aligned(16))) unsigned char lds[];
    Frame F;
    F.lds = (LAS unsigned char*)lds;
    F.MISC = (volatile LAS unsigned*)(F.lds + MISC_OFF);
    F.tid = threadIdx.x; F.lane = F.tid & 63; F.wave = __builtin_amdgcn_readfirstlane(F.tid >> 6);
    F.G = gridDim.x; { const int bx = blockIdx.x; F.vcu = (F.G % 8 == 0) ? (bx % 8) * (F.G / 8) + bx / 8 : bx; }
    unsigned char* ws = args.ws; F.ws = ws; F.out = args.out;
    F.ctl = (gu32*)(ws + WS_CTL);
    F.x = args.in[0]; F.norm_mix = args.in[1]; F.w_in = args.in[2]; F.conv_w = args.in[3]; F.a_log = args.in[4]; F.dt_bias = args.in[5]; F.dn_norm = args.in[6];
    F.w_pa = args.in[7]; F.w_pd = args.in[8]; F.w_out = args.in[9]; F.norm_ffn = args.in[10]; F.w_gate = args.in[11]; F.w_up = args.in[12]; F.w_down = args.in[13]; F.norm_final = args.in[14];
    for (int u = F.tid; u < (LDS_BYTES - LDSCTL_OFF) / 4; u += NWAVES * 64) ((LAS unsigned*)(F.lds + LDSCTL_OFF))[u] = 0u;
    __syncthreads();
    XcdBarrier bar; bar.bar = (unsigned*)(F.ctl + CW_BAR); bar.x = 0; bar.st = nullptr;
    if (!MK_SPLIT) bar = xcd_barrier_post((unsigned*)(F.ctl + CW_BAR), F.MISC + 8);
    const int lo = args.ph_lo, hi = args.ph_hi;
#ifdef ONLY_PH
#define IN(k) ((k) == ONLY_PH && lo <= (k) && (k) < hi)
#else
#define IN(k) (lo <= (k) && (k) < hi)
#endif
#define SEAM(k) do { if (IN(k) && IN((k) + 1)) xcd_barrier(bar); } while (0)
    bf16* U = (bf16*)(ws + WS_U);
    if (IN(0)) { p0_prologue(F); } SEAM(0);
    if (IN(1)) {
        pg8::Gemm g{U, (const bf16*)(ws + WS_WIN), SEQ, 4608, 1024}; pg8::StaticOrder S; S.init(SEQ, 4608, F.G, (int)blockIdx.x);
        pg8::EpiStore E{(bf16*)(ws + WS_QKVA), 4608};
        pg8::gemm_phase<pg8::EpiStore, pg8::StaticOrder, true, true>(F.lds + RING_OFF, g, S, E); } SEAM(1);
    if (IN(2)) { attn_phase(F); } SEAM(2);
    if (IN(3)) { merge_phase(F); } SEAM(3);
    if (IN(4)) {
        pg8::Gemm g{U, (const bf16*)(ws + WS_WIN) + (size_t)4608 * 1024, SEQ, 4096, 1024}; pg8::StaticOrder S; S.init(SEQ, 4096, F.G, (int)blockIdx.x);
        pg8::EpiQkvd E{(bf16*)(ws + WS_QKVD), (bf16*)(ws + WS_HALO), (bf16*)((unsigned char*)F.out + DO_Z)};
        pg8::gemm_phase<pg8::EpiQkvd, pg8::StaticOrder, true, true>(F.lds + RING_OFF, g, S, E); } SEAM(4);
    if (IN(5)) { prep_phase(F); } SEAM(5);
    if (IN(6)) { scan_phase(F); } SEAM(6);
    if (IN(7)) { finalize_delta_phase(F); } SEAM(7);
    if (IN(8)) {
        pg8::Gemm g{(const bf16*)(ws + WS_YA), (const bf16*)(ws + WS_WPA), SEQ, 1024, 512}; pg8::StaticOrder S; S.init(SEQ, 1024, F.G, (int)blockIdx.x);
        pg8::EpiStore E{(bf16*)(ws + WS_T1), 1024};
        pg8::gemm_phase<pg8::EpiStore, pg8::StaticOrder, true, true>(F.lds + RING_OFF, g, S, E); } SEAM(8);
    if (IN(9)) {
        pg8::Gemm g{(const bf16*)((unsigned char*)F.out + DO_OD), (const bf16*)(ws + WS_WPD), SEQ, 1024, 1024}; pg8::StaticOrder S; S.init(SEQ, 1024, F.G, (int)blockIdx.x);
        pg8::EpiStore E{(bf16*)(ws + WS_T2), 1024};
        pg8::gemm_phase<pg8::EpiStore, pg8::StaticOrder, true, true>(F.lds + RING_OFF, g, S, E); } SEAM(9);
    if (IN(10)) {
        pg8::Gemm g{U, (const bf16*)(ws + WS_WIN) + (size_t)8704 * 1024, SEQ, 2048, 1024}; pg8::StaticOrder S; S.init(SEQ, 2048, F.G, (int)blockIdx.x);
        pg8::EpiGateMerge E{(bf16*)(ws + WS_T1), (const bf16*)(ws + WS_T2)};
        pg8::gemm_phase<pg8::EpiGateMerge, pg8::StaticOrder, true, true>(F.lds + RING_OFF, g, S, E); } SEAM(10);
    if (IN(11)) {
        pg8::Gemm g{(const bf16*)(ws + WS_T1), (const bf16*)(ws + WS_WOUT), SEQ, 1024, 1024}; pg8::StaticOrder S; S.init(SEQ, 1024, F.G, (int)blockIdx.x);
        pg8::EpiResid E{F.x, F.out, (bf16*)(ws + WS_HB), (float*)(ws + WS_SSQ1)};
        pg8::gemm_phase<pg8::EpiResid, pg8::StaticOrder, true, true>(F.lds + RING_OFF, g, S, E); } SEAM(11);
    if (IN(12)) {
        pg8::Gemm g{(const bf16*)(ws + WS_HB), (const bf16*)(ws + WS_WGU), SEQ, 5632, 1024}; pg8::StaticOrder S; S.init(SEQ, 5632, F.G, (int)blockIdx.x);
        pg8::EpiSwiglu E{(bf16*)(ws + WS_ACT), (const float*)(ws + WS_SSQ1), EPS};
        pg8::gemm_phase<pg8::EpiSwiglu, pg8::StaticOrder, true, true>(F.lds + RING_OFF, g, S, E); } SEAM(12);
    if (IN(13)) {
        pg8::Gemm g{(const bf16*)(ws + WS_ACT), (const bf16*)(ws + WS_WDN), SEQ, 1024, 2816}; pg8::StaticOrder S; S.init(SEQ, 1024, F.G, (int)blockIdx.x);
        pg8::EpiResid E{F.out, F.out, nullptr, (float*)(ws + WS_SSQ2)};
        pg8::gemm_phase<pg8::EpiResid, pg8::StaticOrder, true, true>(F.lds + RING_OFF, g, S, E); } SEAM(13);
    if (IN(14)) { final_norm_phase(F); }
#undef IN
#undef SEAM
}

extern "C" void kernel_launch(void* const* d_in, const int* in_sizes, int n_in, void* d_out, int out_size, void* d_ws, size_t ws_size, hipStream_t stream) {
    static int grid = 0;
    if (grid == 0) {
        if (n_in != 15 || in_sizes[0] != SEQ * DM || out_size != SEQ * DM || ws_size < WS_END) { fprintf(stderr, "kernel_launch: unexpected shapes (n_in %d, in0 %d, out %d, ws %zu)\n", n_in, n_in > 0 ? in_sizes[0] : -1, out_size, ws_size); grid = -1; return; }
        int dev = 0, cus = 0, per_cu = 0;
        if (hipGetDevice(&dev) != hipSuccess || hipDeviceGetAttribute(&cus, hipDeviceAttributeMultiprocessorCount, dev) != hipSuccess) { grid = -1; return; }
        if (hipFuncSetAttribute((const void*)hyb_fwd, hipFuncAttributeMaxDynamicSharedMemorySize, LDS_BYTES) != hipSuccess) { fprintf(stderr, "kernel_launch: hipFuncSetAttribute failed\n"); grid = -1; return; }
        if (hipOccupancyMaxActiveBlocksPerMultiprocessor(&per_cu, (const void*)hyb_fwd, NWAVES * 64, LDS_BYTES) != hipSuccess || per_cu < 1) { fprintf(stderr, "kernel_launch: occupancy query says %d\n", per_cu); per_cu = 1; }
        (void)hipGetLastError();
        grid = cus;
    }
    if (grid < 0) return;
    (void)hipMemsetAsync((char*)d_ws + WS_CTL, 0, CTL_ZERO_BYTES, stream);
    Args a{};
    for (int i = 0; i < 15; ++i) a.in[i] = (const float*)d_in[i];
    a.out = (float*)d_out; a.ws = (unsigned char*)d_ws;
#if MK_SPLIT
    for (int p = 0; p < N_PHASES; ++p) { a.ph_lo = p; a.ph_hi = p + 1; hipLaunchKernelGGL(hyb_fwd, dim3(grid), dim3(NWAVES * 64), LDS_BYTES, stream, a); }
#else
    a.ph_lo = 0; a.ph_hi = N_PHASES; hipLaunchKernelGGL(hyb_fwd, dim3(grid), dim3(NWAVES * 64), LDS_BYTES, stream, a);
#endif
}
```

```cpp
#include <hip/hip_runtime.h>
#include <cstdio>
#include <cstdint>
namespace pg8 {
#define PG8_LAS __attribute__((address_space(3)))
typedef unsigned short bf16_t;
typedef short bf16x8 __attribute__((ext_vector_type(8)));
typedef float f32x4 __attribute__((ext_vector_type(4)));
typedef unsigned u32x4 __attribute__((ext_vector_type(4)));
constexpr int BM = 256, BK = 64, HALF = 128, HTB = HALF * BK * 2  , STAGE_BYTES = 8 * HTB, NXCD = 8, WGM = 8;

__host__ __device__ __forceinline__ int lds_byte(int r, int c) { const int st = (r >> 4) * 2 + (c >> 5), rr = r & 15, cc = c & 31, ob = rr * 64 + cc * 2; return st * 1024 + (ob ^ (((ob >> 9) & 1) << 5)); }
__host__ __device__ __forceinline__ void stage_rc(int b, int& R, int& C) { const int st = b / 1024, sb = b % 1024, swz = sb ^ (((sb >> 9) & 1) << 5); R = (st >> 1) * 16 + swz / 64; C = (st & 1) * 32 + (swz % 64) / 2; }
__host__ __device__ __forceinline__ int perm32(int rho) { const int n = rho >> 4, i = rho & 15; return 8 * (i >> 2) + 4 * n + (i & 3); }

struct Unit { int pm, pn; };
struct Gemm { const bf16_t* A; const bf16_t* Bt; int M, N, K; };

struct StaticOrder {
    int nM, nN, nwg, G, c;
    __host__ __device__ void init(int M, int N, int G_, int c_) { nM = M / BM; nN = N / BM; nwg = nM * nN; G = G_; c = c_; }
    __host__ __device__ bool next(int i, Unit& u) const {
        const long L = (long)i * G + c; if (L >= nwg) return false;
        int wgid = (int)L; { const int q = nwg / NXCD, r = nwg % NXCD, xcd = wgid % NXCD, off = wgid / NXCD; wgid = (xcd < r ? xcd * (q + 1) : r * (q + 1) + (xcd - r) * q) + off; }
        const int nig = WGM * nN, gid = wgid / nig, fm = gid * WGM, gsz = (nM - fm) < WGM ? (nM - fm) : WGM;
        u.pm = fm + ((wgid % nig) % gsz); u.pn = (wgid % nig) / gsz; return true;
    }
    __device__ __forceinline__ void a_ready(const Unit&) const {}
    __device__ __forceinline__ void done(const Unit&) const {}
};

__device__ __forceinline__ unsigned cvt_pk_bf16(float lo, float hi) { unsigned r; asm volatile("v_cvt_pk_bf16_f32 %0, %1, %2" : "=v"(r) : "v"(lo), "v"(hi)); return r; }
typedef float f32x2 __attribute__((ext_vector_type(2)));
typedef unsigned u32x2 __attribute__((ext_vector_type(2)));
typedef float f32x2c __attribute__((ext_vector_type(2))); typedef __bf16 bf16x2c __attribute__((ext_vector_type(2)));
__device__ __forceinline__ unsigned cvt2(float lo, float hi) { f32x2c v = {lo, hi}; bf16x2c b = __builtin_convertvector(v, bf16x2c); return __builtin_bit_cast(unsigned, b); }
__device__ __forceinline__ u32x4 pack8(const f32x4 a, const f32x4 b) { u32x4 w; w.x = cvt2(a[0], a[1]); w.y = cvt2(a[2], a[3]); w.z = cvt2(b[0], b[1]); w.w = cvt2(b[2], b[3]); return w; }
__device__ __forceinline__ float bf_lo(unsigned w) { return __uint_as_float(w << 16); }
__device__ __forceinline__ float bf_hi(unsigned w) { return __uint_as_float(w & 0xffff0000u); }
__device__ __forceinline__ float sigmoidf_(float x) { return 1.0f / (1.0f + __expf(-x)); }
__device__ __forceinline__ float siluf_(float x) { return x / (1.0f + __expf(-x)); }

struct EpiStore {
    static constexpr bool PERM = true, AFTER_DRAIN = false;
    bf16_t* O; int ldc;
    __device__ __forceinline__ void operator()(const f32x4 (&acc)[2][2][4][2], const Unit& u, int wr, int wc, int fr, int fq) const {
        const int row0 = u.pm * BM + wr * 64 + fr, col0 = u.pn * BM + wc * 32 + 8 * fq;
#pragma unroll
        for (int ai = 0; ai < 2; ++ai)
#pragma unroll
            for (int m = 0; m < 4; ++m) { bf16_t* rowp = O + (size_t)(row0 + ai * HALF + m * 16) * ldc + col0;
#pragma unroll
                for (int bj = 0; bj < 2; ++bj) *(u32x4*)(rowp + bj * HALF) = pack8(acc[ai][bj][m][0], acc[ai][bj][m][1]); }
    }
};
struct EpiQkvd {
    static constexpr bool PERM = true, AFTER_DRAIN = false;
    bf16_t* QKVD; bf16_t* HALO; bf16_t* Z;
    __device__ __forceinline__ void operator()(const f32x4 (&acc)[2][2][4][2], const Unit& u, int wr, int wc, int fr, int fq) const {
        const int row0 = u.pm * BM + wr * 64 + fr;
        if (u.pn < 12) {
            const int col0 = u.pn * BM + wc * 32 + 8 * fq;
#pragma unroll
            for (int ai = 0; ai < 2; ++ai)
#pragma unroll
                for (int m = 0; m < 4; ++m) { const int row = row0 + ai * HALF + m * 16; bf16_t* rowp = QKVD + (size_t)row * 3072 + col0;
                    const int rc = row & 63;
#pragma unroll
                    for (int bj = 0; bj < 2; ++bj) { const u32x4 w = pack8(acc[ai][bj][m][0], acc[ai][bj][m][1]); *(u32x4*)(rowp + bj * HALF) = w;
                        if (rc >= 61) *(u32x4*)(HALO + ((size_t)(row >> 6) * 3 + (rc - 61)) * 3072 + col0 + bj * HALF) = w; } }
        } else {
            const int col0 = (u.pn - 12) * BM + wc * 32 + 8 * fq;
#pragma unroll
            for (int ai = 0; ai < 2; ++ai)
#pragma unroll
                for (int m = 0; m < 4; ++m) { bf16_t* rowp = Z + (size_t)(row0 + ai * HALF + m * 16) * 1024 + col0;
#pragma unroll
                    for (int bj = 0; bj < 2; ++bj) { f32x4 a = acc[ai][bj][m][0], b = acc[ai][bj][m][1];
#pragma unroll
                        for (int i = 0; i < 4; ++i) { a[i] = siluf_(a[i]); b[i] = siluf_(b[i]); }
                        *(u32x4*)(rowp + bj * HALF) = pack8(a, b); } }
        }
    }
};
struct EpiGateMerge {
    static constexpr bool PERM = true, AFTER_DRAIN = false;
    bf16_t* T1; const bf16_t* T2;
    __device__ __forceinline__ void operator()(const f32x4 (&acc)[2][2][4][2], const Unit& u, int wr, int wc, int fr, int fq) const {
        const int row0 = u.pm * BM + wr * 64 + fr, col0 = u.pn * HALF + wc * 32 + 8 * fq;
#pragma unroll
        for (int ai = 0; ai < 2; ++ai)
#pragma unroll
            for (int m = 0; m < 4; ++m) { const size_t off = (size_t)(row0 + ai * HALF + m * 16) * 1024 + col0;
                const u32x4 a = *(const u32x4*)(T1 + off), b = *(const u32x4*)(T2 + off);
                f32x4 o0, o1;
#pragma unroll
                for (int i = 0; i < 2; ++i) {
                    o0[2 * i]     = sigmoidf_(acc[ai][0][m][0][2 * i])     * bf_lo(a[i])     + sigmoidf_(acc[ai][1][m][0][2 * i])     * bf_lo(b[i]);
                    o0[2 * i + 1] = sigmoidf_(acc[ai][0][m][0][2 * i + 1]) * bf_hi(a[i])     + sigmoidf_(acc[ai][1][m][0][2 * i + 1]) * bf_hi(b[i]);
                    o1[2 * i]     = sigmoidf_(acc[ai][0][m][1][2 * i])     * bf_lo(a[2 + i]) + sigmoidf_(acc[ai][1][m][1][2 * i])     * bf_lo(b[2 + i]);
                    o1[2 * i + 1] = sigmoidf_(acc[ai][0][m][1][2 * i + 1]) * bf_hi(a[2 + i]) + sigmoidf_(acc[ai][1][m][1][2 * i + 1]) * bf_hi(b[2 + i]); }
                *(u32x4*)(T1 + off) = pack8(o0, o1); }
    }
};
struct EpiResid {
    static constexpr bool PERM = true, AFTER_DRAIN = false;
    const float* BASE; float* OUT; bf16_t* HB; float* SSQ;
    __device__ __forceinline__ void operator()(const f32x4 (&acc)[2][2][4][2], const Unit& u, int wr, int wc, int fr, int fq) const {
        const int row0 = u.pm * BM + wr * 64 + fr, col0 = u.pn * BM + wc * 32 + 8 * fq;
#pragma unroll
        for (int ai = 0; ai < 2; ++ai)
#pragma unroll
            for (int m = 0; m < 4; ++m) { const int row = row0 + ai * HALF + m * 16; const size_t off = (size_t)row * 1024 + col0; float ss = 0.f;
#pragma unroll
                for (int bj = 0; bj < 2; ++bj) {
                    const f32x4 b0 = *(const f32x4*)(BASE + off + bj * HALF), b1 = *(const f32x4*)(BASE + off + bj * HALF + 4);
                    const f32x4 h0 = b0 + acc[ai][bj][m][0], h1 = b1 + acc[ai][bj][m][1];
                    ss += (h0[0] * h0[0] + h0[1] * h0[1]) + (h0[2] * h0[2] + h0[3] * h0[3]) + (h1[0] * h1[0] + h1[1] * h1[1]) + (h1[2] * h1[2] + h1[3] * h1[3]);
                    *(f32x4*)(OUT + off + bj * HALF) = h0; *(f32x4*)(OUT + off + bj * HALF + 4) = h1;
                    if (HB) *(u32x4*)(HB + off + bj * HALF) = pack8(h0, h1); }
                ss += __shfl_xor(ss, 16); ss += __shfl_xor(ss, 32);
                if (fq == 0) SSQ[(size_t)row * 16 + u.pn * 4 + wc] = ss; }
    }
};
struct EpiSwiglu {
    static constexpr bool PERM = true, AFTER_DRAIN = false;
    bf16_t* ACT; const float* SSQ; float eps;
    __device__ __forceinline__ void operator()(const f32x4 (&acc)[2][2][4][2], const Unit& u, int wr, int wc, int fr, int fq) const {
        const int row0 = u.pm * BM + wr * 64 + fr, col0 = u.pn * HALF + wc * 32 + 8 * fq;
#pragma unroll
        for (int ai = 0; ai < 2; ++ai)
#pragma unroll
            for (int m = 0; m < 4; ++m) { const int row = row0 + ai * HALF + m * 16;
                const f32x4* sp = (const f32x4*)(SSQ + (size_t)row * 16); const f32x4 s0 = sp[0], s1 = sp[1], s2 = sp[2], s3 = sp[3];
                const float ss = ((s0[0] + s0[1]) + (s0[2] + s0[3])) + ((s1[0] + s1[1]) + (s1[2] + s1[3])) + ((s2[0] + s2[1]) + (s2[2] + s2[3])) + ((s3[0] + s3[1]) + (s3[2] + s3[3]));
                const float rs = 1.0f / sqrtf(ss * (1.0f / 1024.0f) + eps);
                f32x4 o0, o1;
#pragma unroll
                for (int i = 0; i < 4; ++i) { o0[i] = siluf_(acc[ai][0][m][0][i] * rs) * (acc[ai][1][m][0][i] * rs); o1[i] = siluf_(acc[ai][0][m][1][i] * rs) * (acc[ai][1][m][1][i] * rs); }
                *(u32x4*)(ACT + (size_t)row * 2816 + col0) = pack8(o0, o1); }
    }
};
template <class Epi, class Sched, bool ALIGN_EPI = false, bool SP2 = false>
__device__ __forceinline__ void gemm_phase(PG8_LAS unsigned char* lds, const Gemm g, const Sched& S, const Epi& E) {
    const int tid = threadIdx.x, wid = __builtin_amdgcn_readfirstlane(tid >> 6), lane = tid & 63, wr = wid >> 2, wc = wid & 3, fr = lane & 15, fq = lane >> 4;
    const int K = g.K, nt = K / BK;
    unsigned voffA[2], voffB[2];
#pragma unroll
    for (int i = 0; i < 2; ++i) { int R, C; stage_rc(tid * 16 + i * 8192, R, C); const int Rb = Epi::PERM ? ((R & ~31) + perm32(R & 31)) : R;
        voffA[i] = (unsigned)(R * K + C) * 2u; voffB[i] = (unsigned)(Rb * K + C) * 2u; }
    const size_t kstep = (size_t)(BK * 2);
    const size_t hstep = (size_t)HALF * K * 2;
    const size_t tstep = 2 * hstep;
    const unsigned ldsw = (unsigned)wid * 1024u;
    const int aoff = lds_byte(wr * 64 + fr, fq * 8), boff = lds_byte(wc * 32 + fr, fq * 8);
#define PG8_SA(b, h) (((b) * 2 + (h)) * HTB)
#define PG8_SB(b, h) ((4 + (b) * 2 + (h)) * HTB)
#define PG8_STAGE(bufoff, gbase, voff) do { _Pragma("unroll") for (int _i = 0; _i < 2; ++_i) \
        __builtin_amdgcn_global_load_lds((const unsigned*)((const char*)(gbase) + (voff)[_i]), (PG8_LAS unsigned*)(lds + (bufoff) + ldsw + _i * 8192), 16, 0, 0); } while (0)
#define PG8_LDA(dst, b, h) do { _Pragma("unroll") for (int m = 0; m < 4; ++m) _Pragma("unroll") for (int k = 0; k < 2; ++k) dst[m][k] = *(const PG8_LAS bf16x8*)(lds + PG8_SA(b, h) + aoff + m * 2048 + k * 1024); } while (0)
#define PG8_LDB(dst, b, h) do { _Pragma("unroll") for (int n = 0; n < 2; ++n) _Pragma("unroll") for (int k = 0; k < 2; ++k) dst[n][k] = *(const PG8_LAS bf16x8*)(lds + PG8_SB(b, h) + boff + n * 2048 + k * 1024); } while (0)
#define PG8_MMA(ai, bj, At, Bt) do { __builtin_amdgcn_s_setprio(1); _Pragma("unroll") for (int m = 0; m < 4; ++m) _Pragma("unroll") for (int n = 0; n < 2; ++n) _Pragma("unroll") for (int k = 0; k < 2; ++k) \
        acc[ai][bj][m][n] = __builtin_amdgcn_mfma_f32_16x16x32_bf16(Bt[n][k], At[m][k], acc[ai][bj][m][n], 0, 0, 0); __builtin_amdgcn_s_setprio(0); } while (0)
#define PG8_WAIT_V(n) asm volatile("s_waitcnt vmcnt(" #n ")" ::: "memory")
#define PG8_WAIT_L(n) asm volatile("s_waitcnt lgkmcnt(" #n ")" ::: "memory")
#define PG8_BAR __builtin_amdgcn_s_barrier()
#define PG8_SCHED __builtin_amdgcn_sched_barrier(0)
    Unit cur, nxt; int ui = 0;
    if (!S.next(0, cur)) return;
    f32x4 acc[2][2][4][2];
#pragma unroll
    for (int a = 0; a < 2; ++a)
#pragma unroll
        for (int b = 0; b < 2; ++b)
#pragma unroll
            for (int m = 0; m < 4; ++m)
#pragma unroll
                for (int n = 0; n < 2; ++n) acc[a][b][m][n] = (f32x4){0.f, 0.f, 0.f, 0.f};
    bf16x8 At[4][2], B0[2][2], B1[2][2];
    const char* cA = (const char*)g.A + (size_t)cur.pm * tstep; const char* cB = (const char*)g.Bt + (size_t)cur.pn * tstep;
    S.a_ready(cur);
    if constexpr (SP2) {
        PG8_STAGE(PG8_SB(0, 0), cB, voffB); PG8_STAGE(PG8_SB(0, 1), cB + hstep, voffB); PG8_STAGE(PG8_SA(0, 0), cA, voffA); PG8_STAGE(PG8_SA(0, 1), cA + hstep, voffA);
        if (wr == 1) PG8_BAR;
        PG8_WAIT_V(2); PG8_BAR;
        PG8_STAGE(PG8_SB(1, 0), cB + kstep, voffB); PG8_STAGE(PG8_SA(1, 0), cA + kstep, voffA); PG8_STAGE(PG8_SB(1, 1), cB + hstep + kstep, voffB);
        PG8_WAIT_V(6); PG8_BAR;
    } else {
        PG8_STAGE(PG8_SB(0, 0), cB, voffB); PG8_STAGE(PG8_SA(0, 0), cA, voffA); PG8_STAGE(PG8_SB(0, 1), cB + hstep, voffB); PG8_STAGE(PG8_SA(0, 1), cA + hstep, voffA);
        if (wr == 1) PG8_BAR;
        PG8_WAIT_V(4); PG8_BAR;
        PG8_STAGE(PG8_SB(1, 0), cB + kstep, voffB); PG8_STAGE(PG8_SA(1, 0), cA + kstep, voffA); PG8_STAGE(PG8_SB(1, 1), cB + hstep + kstep, voffB);
        PG8_WAIT_V(6); PG8_BAR;
    }
    for (;;) {
        const bool has_next = S.next(ui + 1, nxt);
        const char* nA = has_next ? (const char*)g.A + (size_t)nxt.pm * tstep : cA; const char* nB = has_next ? (const char*)g.Bt + (size_t)nxt.pn * tstep : cB;
        for (int t = 0; t < nt; t += 2) {
            const bool last = (t == nt - 2);
            const char* a1 = cA + (size_t)(t + 1) * kstep;
            const char* a2 = last ? nA : cA + (size_t)(t + 2) * kstep; const char* b2 = last ? nB : cB + (size_t)(t + 2) * kstep;
            const char* a3 = a2 + kstep; const char* b3 = b2 + kstep;
            if (last && has_next) S.a_ready(nxt);
            if constexpr (SP2) {
            PG8_LDB(B0, 0, 0); PG8_LDB(B1, 0, 1); PG8_SCHED; PG8_LDA(At, 0, 0); PG8_STAGE(PG8_SA(1, 1), a1 + hstep, voffA);
            PG8_WAIT_V(8); PG8_WAIT_L(0); PG8_BAR; PG8_MMA(0, 0, At, B0); PG8_MMA(0, 1, At, B1); PG8_BAR; PG8_SCHED;
            PG8_LDA(At, 0, 1); PG8_STAGE(PG8_SB(0, 0), b2, voffB); PG8_STAGE(PG8_SB(0, 1), b2 + hstep, voffB); PG8_STAGE(PG8_SA(0, 0), a2, voffA);
            PG8_WAIT_V(8); PG8_WAIT_L(0); PG8_BAR; PG8_MMA(1, 0, At, B0); PG8_MMA(1, 1, At, B1); PG8_BAR; PG8_SCHED;
            PG8_LDB(B0, 1, 0); PG8_LDB(B1, 1, 1); PG8_SCHED; PG8_LDA(At, 1, 0); PG8_STAGE(PG8_SA(0, 1), a2 + hstep, voffA);
            PG8_WAIT_V(8); PG8_WAIT_L(0); PG8_BAR; PG8_MMA(0, 0, At, B0); PG8_MMA(0, 1, At, B1); PG8_BAR; PG8_SCHED;
            PG8_LDA(At, 1, 1); PG8_STAGE(PG8_SB(1, 0), b3, voffB); PG8_STAGE(PG8_SB(1, 1), b3 + hstep, voffB); PG8_STAGE(PG8_SA(1, 0), a3, voffA);
            PG8_WAIT_V(8); PG8_WAIT_L(0); PG8_BAR; PG8_MMA(1, 0, At, B0); PG8_MMA(1, 1, At, B1); PG8_BAR; PG8_SCHED;
            } else {
            PG8_LDB(B0, 0, 0); PG8_SCHED; PG8_LDA(At, 0, 0); PG8_STAGE(PG8_SA(1, 1), a1 + hstep, voffA);
            PG8_WAIT_L(8); PG8_BAR; PG8_WAIT_L(0); PG8_MMA(0, 0, At, B0); PG8_BAR; PG8_SCHED;
            PG8_LDB(B1, 0, 1); PG8_STAGE(PG8_SB(0, 0), b2, voffB);
            PG8_BAR; PG8_WAIT_L(0); PG8_MMA(0, 1, At, B1); PG8_BAR;
            PG8_LDA(At, 0, 1); PG8_STAGE(PG8_SA(0, 0), a2, voffA);
            PG8_BAR; PG8_WAIT_L(0); PG8_MMA(1, 0, At, B0); PG8_BAR; PG8_SCHED;
            PG8_STAGE(PG8_SB(0, 1), b2 + hstep, voffB);
            PG8_WAIT_V(6); PG8_BAR; PG8_MMA(1, 1, At, B1); PG8_BAR;
            PG8_LDB(B0, 1, 0); PG8_SCHED; PG8_LDA(At, 1, 0); PG8_STAGE(PG8_SA(0, 1), a2 + hstep, voffA);
            PG8_WAIT_L(8); PG8_BAR; PG8_WAIT_L(0); PG8_MMA(0, 0, At, B0); PG8_BAR; PG8_SCHED;
            PG8_LDB(B1, 1, 1); PG8_STAGE(PG8_SB(1, 0), b3, voffB);
            PG8_BAR; PG8_WAIT_L(0); PG8_MMA(0, 1, At, B1); PG8_BAR;
            PG8_LDA(At, 1, 1); PG8_STAGE(PG8_SA(1, 0), a3, voffA);
            PG8_BAR; PG8_WAIT_L(0); PG8_MMA(1, 0, At, B0); PG8_BAR; PG8_SCHED;
            PG8_STAGE(PG8_SB(1, 1), b3 + hstep, voffB);
            PG8_WAIT_V(6); PG8_BAR; PG8_MMA(1, 1, At, B1); PG8_BAR;
            }
        }
        if constexpr (ALIGN_EPI) { if (wr == 0) PG8_BAR; }
        if constexpr (!Epi::AFTER_DRAIN) { E(acc, cur, wr, wc, fr, fq); S.done(cur); }
        if (!has_next) break;
#pragma unroll
        for (int a = 0; a < 2; ++a)
#pragma unroll
            for (int b = 0; b < 2; ++b)
#pragma unroll
                for (int m = 0; m < 4; ++m)
#pragma unroll
                    for (int n = 0; n < 2; ++n) acc[a][b][m][n] = (f32x4){0.f, 0.f, 0.f, 0.f};
        cur = nxt; cA = nA; cB = nB; ++ui;
        if constexpr (ALIGN_EPI) { if (wr == 1) PG8_BAR; }
    }
    PG8_WAIT_V(0);
    if constexpr (!ALIGN_EPI) { if (wr == 0) PG8_BAR; }
    PG8_BAR;
    if constexpr (Epi::AFTER_DRAIN) { E.fused(acc, cur, wr, wc, fr, fq, lds, wid, lane); S.done(cur); }
#undef PG8_SA
#undef PG8_SB
#undef PG8_STAGE
#undef PG8_LDA
#undef PG8_LDB
#undef PG8_MMA
#undef PG8_WAIT_V
#undef PG8_WAIT_L
#undef PG8_BAR
#undef PG8_SCHED
}
}
#define GAS __attribute__((address_space(1)))
#define LAS __attribute__((address_space(3)))
typedef unsigned short bf16;
typedef unsigned v4u __attribute__((ext_vector_type(4)));
typedef float f32x4 __attribute__((ext_vector_type(4)));
typedef short bf16x8 __attribute__((ext_vector_type(8)));
typedef GAS unsigned gu32;
typedef GAS unsigned long long gu64;
#define RLX_AGENT __ATOMIC_RELAXED, __HIP_MEMORY_SCOPE_AGENT
#define LDS_WAIT() asm volatile("s_waitcnt lgkmcnt(0)" ::: "memory")
#define VM_WAIT() asm volatile("s_waitcnt vmcnt(0)" ::: "memory")
__device__ __forceinline__ unsigned long long rt() { return __builtin_amdgcn_s_memrealtime(); }
__device__ __forceinline__ unsigned f2bf(float f) { unsigned u = __builtin_bit_cast(unsigned, f); return (u + 0x7fffu + ((u >> 16) & 1u)) >> 16; }
__device__ __forceinline__ unsigned pk2(float lo, float hi) { return f2bf(lo) | (f2bf(hi) << 16); }

#define XB_TMO      128
#define XB_XCNT(j)  (256  + 64 * (j))
#define XB_XSUB(j)  (1280 + 64 * (j))
#define XB_XGEN(j)  (2304 + 64 * (j))
#define XB_TOP      3328
#define XB_TOPGEN   3392
#define XCD_BAR_WORDS 3456
#define XB_SPIN_CAP (1u << 18)

__device__ __forceinline__ unsigned xb_ld(unsigned* p)              { return __hip_atomic_load(p, __ATOMIC_RELAXED, __HIP_MEMORY_SCOPE_AGENT); }
__device__ __forceinline__ unsigned xb_add(unsigned* p, unsigned v) { return __hip_atomic_fetch_add(p, v, __ATOMIC_RELAXED, __HIP_MEMORY_SCOPE_AGENT); }
__device__ __forceinline__ unsigned xb_xcc_id() { return (unsigned)__builtin_amdgcn_s_getreg((3 << 11) | 20) & 0xFu; }
#define XB_SPIN(cond, bar) do { unsigned _sp = 0; while (cond) { __builtin_amdgcn_s_sleep(1); \
    if ((++_sp & 255u) == 0u) { if (xb_ld(&(bar)[XB_TMO])) break; if (_sp > XB_SPIN_CAP) { atomicAdd(&(bar)[XB_TMO], 1u); break; } } } } while (0)

struct XcdBarrier {
    unsigned* bar; unsigned x;
    volatile LAS unsigned* st;
};

__device__ __forceinline__ XcdBarrier xcd_barrier_post(unsigned* bar, volatile LAS unsigned* st) {
    XcdBarrier b; b.bar = bar; b.x = xb_xcc_id(); b.st = st;
    if (threadIdx.x == 0) (void)xb_add(&bar[XB_XCNT(b.x)], 1u);
    return b;
}
__device__ __forceinline__ void xcd_barrier_complete(unsigned* bar, unsigned x, unsigned& nloc, unsigned& nx) {
    const unsigned G = gridDim.x * gridDim.y * gridDim.z;
    unsigned sum, cnt, mine, sp = 0u;
    for (;;) {
        sum = 0u; cnt = 0u; mine = 0u;
#pragma unroll
        for (unsigned j = 0; j < 16; ++j) { const unsigned c = xb_ld(&bar[XB_XCNT(j)]); sum += c; cnt += (c > 0u) ? 1u : 0u; mine = (j == x) ? c : mine; }
        if (sum == G) break;
        __builtin_amdgcn_s_sleep(1);
        if ((++sp & 255u) == 0u) { if (xb_ld(&bar[XB_TMO])) break; if (sp > XB_SPIN_CAP) { atomicAdd(&bar[XB_TMO], 1u); break; } }
    }
    nloc = mine > 0u ? mine : 1u; nx = cnt > 0u ? cnt : 1u;
}

__device__ __forceinline__ void xcd_barrier(const XcdBarrier& b) {
    asm volatile("s_waitcnt vmcnt(0)" ::: "memory");
    __syncthreads();
    if (threadIdx.x == 0) {
        unsigned* bar = b.bar;
        __builtin_amdgcn_s_waitcnt(0);
        unsigned nloc = b.st[0], nx = b.st[1];
        if (nloc == 0u) { xcd_barrier_complete(bar, b.x, nloc, nx); b.st[0] = nloc; b.st[1] = nx; }
        const unsigned old = xb_add(&bar[XB_XSUB(b.x)], 1u);
        const unsigned gen = old / nloc;
        if (old + 1u == (gen + 1u) * nloc) {
            __builtin_amdgcn_fence(__ATOMIC_RELEASE, "agent");
            asm volatile("s_waitcnt vmcnt(0)" ::: "memory");
            const unsigned og = xb_add(&bar[XB_TOP], 1u);
            const unsigned tg = og / nx;
            if (og + 1u == (tg + 1u) * nx) xb_add(&bar[XB_TOPGEN], 1u);
            else XB_SPIN(xb_ld(&bar[XB_TOPGEN]) == tg, bar);
            __builtin_amdgcn_fence(__ATOMIC_ACQUIRE, "agent");
            xb_add(&bar[XB_XGEN(b.x)], 1u);
            asm volatile("s_waitcnt vmcnt(0)" ::: "memory");
        } else {
            XB_SPIN(xb_ld(&bar[XB_XGEN(b.x)]) == gen, bar);
            __builtin_amdgcn_fence(__ATOMIC_ACQUIRE, "agent");
            asm volatile("s_waitcnt vmcnt(0)" ::: "memory");
        }
    }
    __syncthreads();
}

constexpr int NWAVES = 8;
constexpr int SEQ = 16384, DM = 1024, DFF = 2816, DIN = 10768;
constexpr float EPS = 1e-6f;
constexpr float LOG2E = 1.4426950408889634f, LN2 = 0.6931471805599453f;
#ifndef MK_SPLIT
#define MK_SPLIT 0
#endif
constexpr int N_PHASES = 16;

constexpr size_t MiB = 1u << 20;
constexpr size_t WS_CTL = 0, CTL_ZERO_BYTES = 64 * 1024;
constexpr size_t WS_WIN = 2 * MiB;
constexpr size_t WS_WPA = 23 * MiB;
constexpr size_t WS_WPD = 24 * MiB;
constexpr size_t WS_WOUT = 26 * MiB;
constexpr size_t WS_WGU = 28 * MiB;
constexpr size_t WS_WDN = 39 * MiB;
constexpr size_t WS_BETA = 45 * MiB;
constexpr size_t WS_G = WS_BETA + MiB / 2;
constexpr size_t WS_LSE = 46 * MiB;
constexpr size_t WS_GC = 47 * MiB;
constexpr size_t WS_SSQ1 = 48 * MiB;
constexpr size_t WS_SSQ2 = 49 * MiB;
constexpr size_t WS_HALO = 50 * MiB;
constexpr size_t WS_U = 56 * MiB;
constexpr size_t WS_R = 88 * MiB;
constexpr size_t WS_QKVA = WS_R;
constexpr size_t WS_YA = 232 * MiB;
constexpr size_t WS_QKVD = WS_R;
constexpr size_t WS_TQ = 184 * MiB;
constexpr size_t WS_QK = 200 * MiB;
constexpr size_t WS_T1 = 88 * MiB;
constexpr size_t WS_T2 = 120 * MiB;
constexpr size_t WS_HB = 184 * MiB;
constexpr size_t WS_ACT = 88 * MiB;
constexpr size_t WS_END = 256 * MiB;
constexpr size_t DO_OG = 0, DO_Z = 0, DO_OD = 32 * MiB;
constexpr int CW_BAR = 4096;

constexpr int RING_OFF = 0, RING_BYTES = 155648;
constexpr int LDSCTL_OFF = RING_BYTES, MISC_OFF = LDSCTL_OFF + 320;
constexpr int LDS_BYTES = 159744;
static_assert(MISC_OFF + 128 <= LDS_BYTES, "LDS map");

typedef unsigned u32x2 __attribute__((ext_vector_type(2)));
typedef short v4i16_t __attribute__((ext_vector_type(4)));
#define MFMA16(a, b, c) __builtin_amdgcn_mfma_f32_16x16x32_bf16((a), (b), (c), 0, 0, 0)
typedef float f32x2_t __attribute__((ext_vector_type(2))); typedef __bf16 bf16x2_t __attribute__((ext_vector_type(2)));
__device__ __forceinline__ unsigned cvtpk(float lo, float hi) { f32x2_t v = {lo, hi}; bf16x2_t b = __builtin_convertvector(v, bf16x2_t); return __builtin_bit_cast(unsigned, b); }
__device__ __forceinline__ bf16x8 pack8f(const f32x4 a, const f32x4 b) { v4u w; w.x = cvtpk(a[0], a[1]); w.y = cvtpk(a[2], a[3]); w.z = cvtpk(b[0], b[1]); w.w = cvtpk(b[2], b[3]); return __builtin_bit_cast(bf16x8, w); }
__device__ __forceinline__ float bflo(unsigned w) { return __uint_as_float(w << 16); }
__device__ __forceinline__ float bfhi(unsigned w) { return __uint_as_float(w & 0xffff0000u); }
__device__ __forceinline__ u32x2 tr16(const LAS unsigned char* p) { return __builtin_bit_cast(u32x2, __builtin_amdgcn_ds_read_tr16_b64_v4i16((LAS v4i16_t*)p)); }
__device__ __forceinline__ bf16x8 cat8(u32x2 lo, u32x2 hi) { v4u w; w.x = lo.x; w.y = lo.y; w.z = hi.x; w.w = hi.y; return __builtin_bit_cast(bf16x8, w); }
template <int CTRL> __device__ __forceinline__ float dpp_f(float x) { return __int_as_float(__builtin_amdgcn_update_dpp(0, __float_as_int(x), CTRL, 0xf, 0xf, false)); }
__device__ __forceinline__ float wave_sum(float v) {
#pragma unroll
    for (int o = 1; o < 64; o <<= 1) v += __shfl_xor(v, o);
    return v;
}

struct Frame {
    LAS unsigned char* lds;
    volatile LAS unsigned* MISC;
    gu32* ctl;
    int tid, lane, wave;
    int vcu, G;
    const float *x, *norm_mix, *w_in, *conv_w, *a_log, *dt_bias, *dn_norm, *w_pa, *w_pd, *w_out, *norm_ffn, *w_gate, *w_up, *w_down, *norm_final;
    float* out; unsigned char* ws;
};

__device__ __forceinline__ void tr_item(const float* W, int ldw, int k0, int nsrc, bf16* WT, int Kd, int drow, const float* kscale, LAS float* scr, int lane) {
#pragma unroll 8
    for (int i = 0; i < 32; ++i) { const int kk = 2 * i + (lane >> 5); float v = W[(size_t)(k0 + kk) * ldw + nsrc + (lane & 31)]; if (kscale) v *= kscale[k0 + kk]; scr[kk * 33 + (lane & 31)] = v; }
    LDS_WAIT(); asm volatile("" ::: "memory");
    const int c = lane & 7;
#pragma unroll
    for (int j = 0; j < 4; ++j) { const int n = (lane >> 3) + 8 * j; const LAS float* s = scr + (8 * c) * 33 + n;
        v4u o; o.x = pk2(s[0 * 33], s[1 * 33]); o.y = pk2(s[2 * 33], s[3 * 33]); o.z = pk2(s[4 * 33], s[5 * 33]); o.w = pk2(s[6 * 33], s[7 * 33]);
        *(GAS v4u*)(WT + (size_t)(drow + n) * Kd + k0 + 8 * c) = o; }
    LDS_WAIT(); asm volatile("" ::: "memory");
}
__device__ __forceinline__ void p0_prologue(Frame& F) {
    LAS float* scr = (LAS float*)(F.lds + RING_OFF + F.wave * 16384);
    const int gw = F.vcu * NWAVES + F.wave, NGW = F.G * NWAVES;
    bf16* WIN = (bf16*)(F.ws + WS_WIN); bf16* WPA = (bf16*)(F.ws + WS_WPA); bf16* WPD = (bf16*)(F.ws + WS_WPD); bf16* WOUT = (bf16*)(F.ws + WS_WOUT);
    bf16* WGU = (bf16*)(F.ws + WS_WGU); bf16* WDN = (bf16*)(F.ws + WS_WDN);
    constexpr int I0 = 16 * 272, I1 = 16 * 64, I2 = 8 * 32, I3 = 16 * 32, I4 = 16 * 32, I5 = 16 * 88, I6 = 16 * 88, I7 = 44 * 32;
    constexpr int NITEMS = I0 + I1 + I2 + I3 + I4 + I5 + I6 + I7;
    for (int it = gw; it < NITEMS; it += NGW) {
        int r = it;
        if (r < I0) { const int kb = r / 272, nb = r % 272; tr_item(F.w_in, DIN, 64 * kb, 32 * nb, WIN, 1024, 32 * nb, nullptr, scr, F.lane); continue; } r -= I0;
        if (r < I1) { const int kb = r / 64, nb = r % 64, j0 = 32 * nb, which = j0 >> 10, jj = j0 & 1023;
            tr_item(F.w_in, DIN, 64 * kb, 8720 + j0, WIN, 1024, 8704 + 256 * (jj >> 7) + 128 * which + (jj & 127), nullptr, scr, F.lane); continue; } r -= I1;
        if (r < I2) { const int kb = r / 32, nb = r % 32; tr_item(F.w_pa, 1024, 64 * kb, 32 * nb, WPA, 512, 32 * nb, nullptr, scr, F.lane); continue; } r -= I2;
        if (r < I3) { const int kb = r / 32, nb = r % 32; tr_item(F.w_pd, 1024, 64 * kb, 32 * nb, WPD, 1024, 32 * nb, nullptr, scr, F.lane); continue; } r -= I3;
        if (r < I4) { const int kb = r / 32, nb = r % 32; tr_item(F.w_out, 1024, 64 * kb, 32 * nb, WOUT, 1024, 32 * nb, nullptr, scr, F.lane); continue; } r -= I4;
        if (r < I5) { const int kb = r / 88, nb = r % 88, j0 = 32 * nb; tr_item(F.w_gate, DFF, 64 * kb, j0, WGU, 1024, 256 * (j0 >> 7) + (j0 & 127), F.norm_ffn, scr, F.lane); continue; } r -= I5;
        if (r < I6) { const int kb = r / 88, nb = r % 88, j0 = 32 * nb; tr_item(F.w_up, DFF, 64 * kb, j0, WGU, 1024, 256 * (j0 >> 7) + 128 + (j0 & 127), F.norm_ffn, scr, F.lane); continue; } r -= I6;
        { const int kb = r / 32, nb = r % 32; tr_item(F.w_down, 1024, 64 * kb, 32 * nb, WDN, DFF, 32 * nb, nullptr, scr, F.lane); }
    }
    __syncthreads();
    LAS float* wba = (LAS float*)(F.lds + RING_OFF);
    for (int idx = F.tid; idx < 16384; idx += NWAVES * 64) { const int k = idx >> 4, c = idx & 15; const int ln = (k & 255) >> 2, i = k & 3, j = k >> 8;
        wba[((((j * 4 + i) * 4 + (c >> 2)) * 64 + ln) << 2) + (c & 3)] = F.w_in[(size_t)k * DIN + 8704 + c]; }
    __syncthreads();
    bf16* U = (bf16*)(F.ws + WS_U); float* BETA = (float*)(F.ws + WS_BETA); float* GG = (float*)(F.ws + WS_G);
    for (int m = gw; m < SEQ; m += NGW) {
        asm volatile("" ::: "memory");
        const GAS f32x4* xr = (const GAS f32x4*)(F.x + (size_t)m * DM) + F.lane;
        f32x4 v[4]; float s = 0.f;
#pragma unroll
        for (int j = 0; j < 4; ++j) { v[j] = xr[64 * j]; s += (v[j].x * v[j].x + v[j].y * v[j].y) + (v[j].z * v[j].z + v[j].w * v[j].w); }
        const float rstd = 1.0f / sqrtf(wave_sum(s) * (1.f / DM) + EPS);
        GAS unsigned long long* o8 = (GAS unsigned long long*)(U + (size_t)m * DM) + F.lane;
        float acc[16];
#pragma unroll
        for (int c = 0; c < 16; ++c) acc[c] = 0.f;
#pragma unroll
        for (int j = 0; j < 4; ++j) { const f32x4 nm = ((const GAS f32x4*)F.norm_mix)[F.lane + 64 * j]; v[j] = v[j] * rstd * nm;
            o8[64 * j] = (unsigned long long)cvtpk(v[j].x, v[j].y) | ((unsigned long long)cvtpk(v[j].z, v[j].w) << 32);
#pragma unroll
            for (int i = 0; i < 4; ++i)
#pragma unroll
                for (int c4 = 0; c4 < 4; ++c4) { const f32x4 w = *(const LAS f32x4*)(wba + ((((j * 4 + i) * 4 + c4) * 64 + F.lane) << 2));
                    acc[4 * c4 + 0] += v[j][i] * w[0]; acc[4 * c4 + 1] += v[j][i] * w[1]; acc[4 * c4 + 2] += v[j][i] * w[2]; acc[4 * c4 + 3] += v[j][i] * w[3]; } }
        float mine = 0.f;
#pragma unroll
        for (int c = 0; c < 16; ++c) { const float t = wave_sum(acc[c]); mine = (F.lane == c) ? t : mine; }
        if (F.lane < 8) BETA[(size_t)m * 8 + F.lane] = 1.0f / (1.0f + expf(-mine));
        else if (F.lane < 16) { const int hh = F.lane - 8; const float xx = mine + F.dt_bias[hh]; const float sp = fmaxf(xx, 0.f) + log1pf(expf(-fabsf(xx))); GG[(size_t)m * 8 + hh] = -expf(F.a_log[hh]) * sp; }
    }
}

__device__ __forceinline__ void attn_phase(Frame& F) {
    const bf16* QKV = (const bf16*)(F.ws + WS_QKVA);
    bf16* OG = (bf16*)((unsigned char*)F.out + DO_OG); float* LSE = (float*)(F.ws + WS_LSE);
    LAS unsigned char* Ks = F.lds + RING_OFF; LAS unsigned char* Vs = Ks + 256 * 272;
    const int lane = F.lane, w = F.wave, l15 = lane & 15, q4 = lane >> 4;
    for (int unit = F.vcu; unit < 12 * 128; unit += F.G) {
        const int h = unit >> 7, tau = unit & 127, gi = h >> 2, hh = h & 3, sh = 2 * gi, d = 1 << sh, r = tau & (d - 1), n = tau >> sh;
        { const int key = F.tid >> 1, half = F.tid & 1; const int sidx = (n - 1) * 128 + key;
            v4u kv[8], vv[8];
            if (sidx >= 0) { const size_t pos = (size_t)sidx * d + r;
                const GAS v4u* kp = (const GAS v4u*)(QKV + pos * 4608 + 1536 + h * 128 + half * 64); const GAS v4u* vp = (const GAS v4u*)(QKV + pos * 4608 + 3072 + h * 128 + half * 64);
#pragma unroll
                for (int i = 0; i < 8; ++i) { kv[i] = kp[i]; vv[i] = vp[i]; } }
            else {
#pragma unroll
                for (int i = 0; i < 8; ++i) { kv[i] = (v4u){0u, 0u, 0u, 0u}; vv[i] = (v4u){0u, 0u, 0u, 0u}; } }
#pragma unroll
            for (int i = 0; i < 8; ++i) { *(LAS v4u*)(Ks + key * 272 + half * 128 + i * 16) = kv[i]; *(LAS v4u*)(Vs + key * 288 + half * 128 + i * 16) = vv[i]; } }
        const int iq = 16 * w + l15; const size_t posq = (size_t)(n * 128 + iq) * d + r;
        bf16x8 qf[4];
#pragma unroll
        for (int ks = 0; ks < 4; ++ks) qf[ks] = *(const GAS bf16x8*)(QKV + posq * 4608 + h * 128 + 32 * ks + 8 * q4);
        __syncthreads();
        f32x4 sacc[9];
#pragma unroll
        for (int t = 0; t < 9; ++t) { sacc[t] = (f32x4){0.f, 0.f, 0.f, 0.f}; const LAS unsigned char* kp = Ks + (16 * (w + t) + l15) * 272 + 16 * q4;
#pragma unroll
            for (int ks = 0; ks < 4; ++ks) { const bf16x8 a = *(const LAS bf16x8*)(kp + 64 * ks); sacc[t] = MFMA16(a, qf[ks], sacc[t]); } }
        const float slope = exp2f(-8.0f * (float)(h + 1) / 12.0f);
        const float c1 = 0.08838834764831845f * LOG2E, c2 = slope * (float)d * LOG2E;
        float mx = -INFINITY;
#pragma unroll
        for (int t = 0; t < 9; ++t)
#pragma unroll
            for (int rg = 0; rg < 4; ++rg) { const int delta = 128 + l15 - 16 * t - 4 * q4 - rg; const int j = 16 * (w + t) + 4 * q4 + rg;
                const bool valid = (delta >= 0) && (delta <= 128) && (n > 0 || j >= 128);
                const float s = valid ? (sacc[t][rg] * c1 - c2 * (float)delta) : -INFINITY; sacc[t][rg] = s; mx = fmaxf(mx, s); }
        mx = fmaxf(mx, __shfl_xor(mx, 16)); mx = fmaxf(mx, __shfl_xor(mx, 32));
        float den = 0.f;
#pragma unroll
        for (int t = 0; t < 9; ++t)
#pragma unroll
            for (int rg = 0; rg < 4; ++rg) { const float p = exp2f(sacc[t][rg] - mx); den += p; sacc[t][rg] = p; }
        den += __shfl_xor(den, 16); den += __shfl_xor(den, 32);
        f32x4 oacc[8];
#pragma unroll
        for (int mt = 0; mt < 8; ++mt) oacc[mt] = (f32x4){0.f, 0.f, 0.f, 0.f};
#pragma unroll
        for (int u = 0; u < 5; ++u) { const bf16x8 pk = pack8f(sacc[2 * u], (u < 4) ? sacc[(u < 4) ? 2 * u + 1 : 0] : (f32x4){0.f, 0.f, 0.f, 0.f});
            const int kt0 = w + 2 * u, kt1 = (w + 2 * u + 1 < 16) ? w + 2 * u + 1 : 15;
            const LAS unsigned char* v0p = Vs + (16 * kt0 + 4 * q4 + (l15 >> 2)) * 288 + 8 * (l15 & 3); const LAS unsigned char* v1p = Vs + (16 * kt1 + 4 * q4 + (l15 >> 2)) * 288 + 8 * (l15 & 3);
#pragma unroll
            for (int mt = 0; mt < 8; ++mt) { const bf16x8 a = cat8(tr16(v0p + 32 * mt), tr16(v1p + 32 * mt)); oacc[mt] = MFMA16(a, pk, oacc[mt]); } }
        const float inv = 1.0f / den;
        bf16* op = OG + ((size_t)gi * SEQ + posq) * 512 + hh * 128 + 4 * q4;
#pragma unroll
        for (int mt = 0; mt < 8; ++mt) { u32x2 wv; wv.x = cvtpk(oacc[mt][0] * inv, oacc[mt][1] * inv); wv.y = cvtpk(oacc[mt][2] * inv, oacc[mt][3] * inv); *(GAS u32x2*)(op + 16 * mt) = wv; }
        if (q4 == 0) LSE[((size_t)gi * SEQ + posq) * 4 + hh] = (mx + log2f(den)) * LN2;
        __syncthreads();
    }
}

__device__ __forceinline__ void merge_phase(Frame& F) {
    const bf16* OG = (const bf16*)((unsigned char*)F.out + DO_OG); const float* LSE = (const float*)(F.ws + WS_LSE); bf16* YA = (bf16*)(F.ws + WS_YA);
    const int gw = F.vcu * NWAVES + F.wave, NGW = F.G * NWAVES, hh = F.lane >> 4;
    for (int p = gw; p < SEQ; p += NGW) {
        const float l0 = LSE[((size_t)0 * SEQ + p) * 4 + hh], l1 = LSE[((size_t)1 * SEQ + p) * 4 + hh], l2 = LSE[((size_t)2 * SEQ + p) * 4 + hh];
        const float m = fmaxf(l0, fmaxf(l1, l2)); float w0 = expf(l0 - m), w1 = expf(l1 - m), w2 = expf(l2 - m); const float inv = 1.0f / (w0 + w1 + w2); w0 *= inv; w1 *= inv; w2 *= inv;
        const v4u a = *(const GAS v4u*)(OG + ((size_t)0 * SEQ + p) * 512 + F.lane * 8), b = *(const GAS v4u*)(OG + ((size_t)1 * SEQ + p) * 512 + F.lane * 8), c = *(const GAS v4u*)(OG + ((size_t)2 * SEQ + p) * 512 + F.lane * 8);
        v4u o;
#pragma unroll
        for (int i = 0; i < 4; ++i) o[i] = cvtpk(w0 * bflo(a[i]) + w1 * bflo(b[i]) + w2 * bflo(c[i]), w0 * bfhi(a[i]) + w1 * bfhi(b[i]) + w2 * bfhi(c[i]));
        *(GAS v4u*)(YA + (size_t)p * 512 + F.lane * 8) = o;
    }
}

__device__ __forceinline__ void prep_phase(Frame& F) {
    bf16* QKVD = (bf16*)(F.ws + WS_QKVD); const bf16* HALO = (const bf16*)(F.ws + WS_HALO);
    const float* BETA = (const float*)(F.ws + WS_BETA); const float* GG = (const float*)(F.ws + WS_G); float* GC = (float*)(F.ws + WS_GC);
    bf16* TQ = (bf16*)(F.ws + WS_TQ); bf16* QK = (bf16*)(F.ws + WS_QK);
    const int gw = F.vcu * NWAVES + F.wave, NGW = F.G * NWAVES, lane = F.lane, l15 = lane & 15, q4 = lane >> 4;
    LAS float* A = (LAS float*)(F.lds + RING_OFF + F.wave * 16896); LAS float* gcs = A + 4096; LAS float* bts = gcs + 64;
    for (int task = gw; task < 2048; task += NGW) {
        const int n = task >> 3, h = task & 7;
        { float gv = GG[(size_t)(64 * n + lane) * 8 + h];
#pragma unroll
            for (int off = 1; off < 64; off <<= 1) { const float t = __shfl_up(gv, off); if (lane >= off) gv += t; }
            gcs[lane] = gv; bts[lane] = BETA[(size_t)(64 * n + lane) * 8 + h]; GC[(size_t)task * 64 + lane] = gv; }
#pragma unroll 1
        for (int sg = 0; sg < 3; ++sg) {
            const int col = sg * 1024 + h * 128 + 8 * l15;
            f32x4 wlo[4], whi[4];
#pragma unroll
            for (int j = 0; j < 4; ++j) { wlo[j] = *(const GAS f32x4*)(F.conv_w + (size_t)j * 3072 + col); whi[j] = *(const GAS f32x4*)(F.conv_w + (size_t)j * 3072 + col + 4); }
            bf16* base = QKVD + (size_t)(64 * n + 16 * q4) * 3072 + col;
            v4u pw[3];
            if (q4 > 0) {
#pragma unroll
                for (int j = 0; j < 3; ++j) pw[j] = *(const GAS v4u*)(base - (size_t)(3 - j) * 3072); }
            else if (n > 0) {
#pragma unroll
                for (int j = 0; j < 3; ++j) pw[j] = *(const GAS v4u*)(HALO + ((size_t)(n - 1) * 3 + j) * 3072 + col); }
            else { pw[0] = pw[1] = pw[2] = (v4u){0u, 0u, 0u, 0u}; }
            asm volatile("s_waitcnt vmcnt(0)" ::: "memory");
            const float sc = (sg == 0) ? 0.08838834764831845f : 1.0f;
#pragma unroll 4
            for (int t = 0; t < 16; ++t) {
                const v4u xv = *(const GAS v4u*)(base + (size_t)t * 3072);
                float y[8];
#pragma unroll
                for (int e = 0; e < 4; ++e) {
                    const float a0 = bflo(pw[0][e]), a1 = bflo(pw[1][e]), a2 = bflo(pw[2][e]), a3 = bflo(xv[e]);
                    const float b0 = bfhi(pw[0][e]), b1 = bfhi(pw[1][e]), b2 = bfhi(pw[2][e]), b3 = bfhi(xv[e]);
                    const int c0 = 2 * e, c1 = 2 * e + 1;
                    const float w00 = (c0 < 4) ? wlo[0][c0 & 3] : whi[0][c0 & 3], w01 = (c0 < 4) ? wlo[1][c0 & 3] : whi[1][c0 & 3], w02 = (c0 < 4) ? wlo[2][c0 & 3] : whi[2][c0 & 3], w03 = (c0 < 4) ? wlo[3][c0 & 3] : whi[3][c0 & 3];
                    const float w10 = (c1 < 4) ? wlo[0][c1 & 3] : whi[0][c1 & 3], w11 = (c1 < 4) ? wlo[1][c1 & 3] : whi[1][c1 & 3], w12 = (c1 < 4) ? wlo[2][c1 & 3] : whi[2][c1 & 3], w13 = (c1 < 4) ? wlo[3][c1 & 3] : whi[3][c1 & 3];
                    float ya = w00 * a0 + w01 * a1 + w02 * a2 + w03 * a3, yb = w10 * b0 + w11 * b1 + w12 * b2 + w13 * b3;
                    y[c0] = ya / (1.0f + __expf(-ya)); y[c1] = yb / (1.0f + __expf(-yb)); }
                float rs = 1.0f;
                if (sg != 2) { float ss = 0.f;
#pragma unroll
                    for (int e = 0; e < 8; ++e) ss += y[e] * y[e];
                    ss += dpp_f<0xB1>(ss); ss += dpp_f<0x4E>(ss); ss += dpp_f<0x141>(ss); ss += dpp_f<0x140>(ss);
                    rs = sc / sqrtf(ss + EPS); }
                v4u st; st.x = cvtpk(y[0] * rs, y[1] * rs); st.y = cvtpk(y[2] * rs, y[3] * rs); st.z = cvtpk(y[4] * rs, y[5] * rs); st.w = cvtpk(y[6] * rs, y[7] * rs);
                *(GAS v4u*)(base + (size_t)t * 3072) = st;
                pw[0] = pw[1]; pw[1] = pw[2]; pw[2] = xv; } }
        asm volatile("s_waitcnt vmcnt(0) lgkmcnt(0)" ::: "memory");
        bf16x8 kf[4][4];
        const bf16* rp0 = QKVD + (size_t)(64 * n + l15) * 3072 + h * 128 + 8 * q4;
#pragma unroll
        for (int mt = 0; mt < 4; ++mt)
#pragma unroll
            for (int ks = 0; ks < 4; ++ks) kf[mt][ks] = *(const GAS bf16x8*)(rp0 + (size_t)mt * (16 * 3072) + 1024 + 32 * ks);
        bf16* qkb = QK + (size_t)task * 4096 + (4 * q4) * 64 + l15;
        LAS float* Ab = A + (4 * q4) * 64 + l15;
#pragma unroll
        for (int mt = 0; mt < 4; ++mt) { const f32x4 gi4 = *(const LAS f32x4*)(gcs + 16 * mt + 4 * q4), bi4 = *(const LAS f32x4*)(bts + 16 * mt + 4 * q4);
            bf16x8 qf[4];
#pragma unroll
            for (int ks = 0; ks < 4; ++ks) qf[ks] = *(const GAS bf16x8*)(rp0 + (size_t)mt * (16 * 3072) + 32 * ks);
#pragma unroll
            for (int nt = 0; nt < 4; ++nt) {
                if (nt <= mt) { const float gj = gcs[16 * nt + l15];
                    f32x4 akk = (f32x4){0.f, 0.f, 0.f, 0.f}, aqk = (f32x4){0.f, 0.f, 0.f, 0.f};
#pragma unroll
                    for (int ks = 0; ks < 4; ++ks) { akk = MFMA16(kf[mt][ks], kf[nt][ks], akk); aqk = MFMA16(qf[ks], kf[nt][ks], aqk); }
#pragma unroll
                    for (int rg = 0; rg < 4; ++rg) { const int i = 16 * mt + 4 * q4 + rg, j = 16 * nt + l15; const float dec = __expf(fminf(gi4[rg] - gj, 0.f));
                        Ab[(16 * mt + rg) * 64 + 16 * nt] = (i > j) ? bi4[rg] * akk[rg] * dec : 0.f;
                        qkb[(16 * mt + rg) * 64 + 16 * nt] = (bf16)f2bf((i >= j) ? aqk[rg] * dec : 0.f); }
                } else {
#pragma unroll
                    for (int rg = 0; rg < 4; ++rg) { Ab[(16 * mt + rg) * 64 + 16 * nt] = 0.f; qkb[(16 * mt + rg) * 64 + 16 * nt] = (bf16)0; }
                } }
            asm volatile("" ::: "memory"); }
        LDS_WAIT(); asm volatile("" ::: "memory");
        bf16* tg = TQ + (size_t)task * 4096 + lane;
        float Tc[64];
#pragma unroll
        for (int i = 0; i < 64; ++i) Tc[i] = 0.f;
#pragma unroll
        for (int i = 0; i < 64; ++i) { float s = (i == lane) ? 1.f : 0.f;
#pragma unroll
            for (int j4 = 0; j4 < i; j4 += 4) { const f32x4 a = *(const LAS f32x4*)(A + i * 64 + j4); s -= a[0] * Tc[j4]; s -= a[1] * Tc[j4 + 1]; s -= a[2] * Tc[j4 + 2]; s -= a[3] * Tc[j4 + 3]; }
            Tc[i] = s; tg[i * 64] = (bf16)f2bf(s);
            asm volatile("" ::: "memory"); }
        LDS_WAIT(); asm volatile("" ::: "memory");
    }
}

constexpr int SC_K = 0, SC_Q = 17408, SC_V = 34816, SC_T = 45056, SC_QK = 54272, SC_GC = 63488, SC_BT = 63744, SC_BUF = 64000;
constexpr int SC_OSC = 2 * SC_BUF;
static_assert(SC_OSC + 4 * 2048 <= RING_BYTES, "scan LDS");
constexpr int SGRP = 8, SLEN = 32;
constexpr size_t WS_MG = 216 * MiB;
constexpr size_t WS_BG = 220 * MiB;
__device__ __forceinline__ bf16x8 ld2x64(const LAS unsigned char* p) { const u32x2 a = *(const LAS u32x2*)p, b = *(const LAS u32x2*)(p + 32); return cat8(a, b); }
#define SC_BARRIER() asm volatile("s_waitcnt lgkmcnt(0)\n\ts_barrier" ::: "memory")
template <bool WV, bool WO>
__device__ __forceinline__ void scan_steps(Frame& F, const int head, const int n0, const int nsteps, const int colbase, f32x4 (&S)[8]) {
    const bf16* QKVD = (const bf16*)(F.ws + WS_QKVD); const bf16* TQ = (const bf16*)(F.ws + WS_TQ); const bf16* QK = (const bf16*)(F.ws + WS_QK);
    const float* GC = (const float*)(F.ws + WS_GC); const float* BETA = (const float*)(F.ws + WS_BETA);
    bf16* OD = (bf16*)((unsigned char*)F.out + DO_OD);
    const int lane = F.lane, w = F.wave, l15 = lane & 15, q4 = lane >> 4;
    const int tl = F.tid - 256;
    const int vloc = 16 * (w & 3), v0 = colbase + vloc;
    LAS unsigned char* L = F.lds + RING_OFF; LAS unsigned char* osc = L + SC_OSC + (w & 3) * 2048;
    v4u rk[4], rq[4], rv[2], rt[2], rqk[2]; float rs = 0.f;
#define SC_LOAD(n_) do { const int task_ = (n_) * 8 + head; \
        _Pragma("unroll") for (int i_ = 0; i_ < 4; ++i_) { const int id_ = tl + 256 * i_, row_ = id_ >> 4, pc_ = id_ & 15; const bf16* src_ = QKVD + (size_t)(64 * (n_) + row_) * 3072 + head * 128 + pc_ * 8; \
            rk[i_] = *(const GAS v4u*)(src_ + 1024); if (WO) rq[i_] = *(const GAS v4u*)(src_); } \
        _Pragma("unroll") for (int i_ = 0; i_ < 2; ++i_) { const int id_ = tl + 256 * i_; \
            if (WV) rv[i_] = *(const GAS v4u*)(QKVD + (size_t)(64 * (n_) + (id_ >> 3)) * 3072 + 2048 + head * 128 + colbase + (id_ & 7) * 8); \
            rt[i_] = *(const GAS v4u*)(TQ + (size_t)task_ * 4096 + id_ * 8); if (WO) rqk[i_] = *(const GAS v4u*)(QK + (size_t)task_ * 4096 + id_ * 8); } \
        if (tl < 64) rs = GC[(size_t)task_ * 64 + tl]; else if (tl < 128) rs = BETA[(size_t)(64 * (n_) + tl - 64) * 8 + head]; } while (0)
#define SC_WRITE(b_) do { LAS unsigned char* B_ = L + (b_) * SC_BUF; \
        _Pragma("unroll") for (int i_ = 0; i_ < 4; ++i_) { const int id_ = tl + 256 * i_, row_ = id_ >> 4, pc_ = id_ & 15; \
            *(LAS v4u*)(B_ + SC_K + row_ * 272 + pc_ * 16) = rk[i_]; if (WO) *(LAS v4u*)(B_ + SC_Q + row_ * 272 + pc_ * 16) = rq[i_]; } \
        _Pragma("unroll") for (int i_ = 0; i_ < 2; ++i_) { const int id_ = tl + 256 * i_; \
            if (WV) *(LAS v4u*)(B_ + SC_V + (id_ >> 3) * 160 + (id_ & 7) * 16) = rv[i_]; \
            *(LAS v4u*)(B_ + SC_T + (id_ >> 3) * 144 + (id_ & 7) * 16) = rt[i_]; if (WO) *(LAS v4u*)(B_ + SC_QK + (id_ >> 3) * 144 + (id_ & 7) * 16) = rqk[i_]; } \
        if (tl < 64) *(LAS float*)(B_ + SC_GC + tl * 4) = rs; else if (tl < 128) *(LAS float*)(B_ + SC_BT + (tl - 64) * 4) = rs; } while (0)
    if (w >= 4) { SC_LOAD(n0); SC_WRITE(0); }
    SC_BARRIER();
    for (int i = 0; i < nsteps; ++i) {
        if (w >= 4) {
            if (i + 1 < nsteps) { SC_LOAD(n0 + i + 1); SC_WRITE((i + 1) & 1); }
        } else {
            const int n = n0 + i;
            const LAS unsigned char* B = L + (i & 1) * SC_BUF;
            bf16x8 SB[4];
#pragma unroll
            for (int s = 0; s < 4; ++s) SB[s] = pack8f(S[2 * s], S[2 * s + 1]);
            f32x4 kS[4], qS[4];
#pragma unroll
            for (int mt = 0; mt < 4; ++mt) { kS[mt] = (f32x4){0.f, 0.f, 0.f, 0.f}; qS[mt] = (f32x4){0.f, 0.f, 0.f, 0.f};
#pragma unroll
                for (int s = 0; s < 4; ++s) { kS[mt] = MFMA16(ld2x64(B + SC_K + (16 * mt + l15) * 272 + 64 * s + 8 * q4), SB[s], kS[mt]);
                    if (WO) qS[mt] = MFMA16(ld2x64(B + SC_Q + (16 * mt + l15) * 272 + 64 * s + 8 * q4), SB[s], qS[mt]); } }
            const float gl = *(const LAS float*)(B + SC_GC + 63 * 4);
            f32x4 rhs[4], egc[4], edl[4];
#pragma unroll
            for (int mt = 0; mt < 4; ++mt) { const f32x4 g4 = *(const LAS f32x4*)(B + SC_GC + (16 * mt + 4 * q4) * 4), b4 = *(const LAS f32x4*)(B + SC_BT + (16 * mt + 4 * q4) * 4);
                f32x4 vv = (f32x4){0.f, 0.f, 0.f, 0.f};
                if (WV) { const u32x2 vt = tr16(B + SC_V + (16 * mt + 4 * q4 + (l15 >> 2)) * 160 + (vloc + 4 * (l15 & 3)) * 2); vv = (f32x4){bflo(vt.x), bfhi(vt.x), bflo(vt.y), bfhi(vt.y)}; }
#pragma unroll
                for (int rg = 0; rg < 4; ++rg) { egc[mt][rg] = __expf(g4[rg]); edl[mt][rg] = __expf(gl - g4[rg]); rhs[mt][rg] = b4[rg] * (vv[rg] - egc[mt][rg] * kS[mt][rg]); } }
            bf16x8 RB[2]; RB[0] = pack8f(rhs[0], rhs[1]); RB[1] = pack8f(rhs[2], rhs[3]);
            f32x4 uu[4];
#pragma unroll
            for (int mt = 0; mt < 4; ++mt) { uu[mt] = (f32x4){0.f, 0.f, 0.f, 0.f};
#pragma unroll
                for (int s = 0; s < 2; ++s) if (s <= (mt >> 1)) uu[mt] = MFMA16(ld2x64(B + SC_T + (16 * mt + l15) * 144 + 64 * s + 8 * q4), RB[s], uu[mt]); }
            if (WO) {
                bf16x8 UB[2]; UB[0] = pack8f(uu[0], uu[1]); UB[1] = pack8f(uu[2], uu[3]);
#pragma unroll
                for (int mt = 0; mt < 4; ++mt) { f32x4 o = egc[mt] * qS[mt];
#pragma unroll
                    for (int s = 0; s < 2; ++s) if (s <= (mt >> 1)) o = MFMA16(ld2x64(B + SC_QK + (16 * mt + l15) * 144 + 64 * s + 8 * q4), UB[s], o);
#pragma unroll
                    for (int rg = 0; rg < 4; ++rg) *(LAS unsigned short*)(osc + (16 * mt + 4 * q4 + rg) * 32 + l15 * 2) = (unsigned short)(cvtpk(o[rg], 0.f) & 0xffffu); }
                { const v4u o0 = *(const LAS v4u*)(osc + lane * 32), o1 = *(const LAS v4u*)(osc + lane * 32 + 16);
                    bf16* op = OD + (size_t)(64 * n + lane) * 1024 + head * 128 + v0; *(GAS v4u*)op = o0; *(GAS v4u*)(op + 8) = o1; }
            }
            bf16x8 DB[2]; DB[0] = pack8f(uu[0] * edl[0], uu[1] * edl[1]); DB[1] = pack8f(uu[2] * edl[2], uu[3] * edl[3]);
            const float egl = __expf(gl);
#pragma unroll
            for (int dt = 0; dt < 8; ++dt) { S[dt] = S[dt] * egl;
#pragma unroll
                for (int s = 0; s < 2; ++s) { const LAS unsigned char* kp = B + SC_K + (32 * s + 4 * q4 + (l15 >> 2)) * 272 + (16 * dt + 4 * (l15 & 3)) * 2;
                    S[dt] = MFMA16(cat8(tr16(kp), tr16(kp + 16 * 272)), DB[s], S[dt]); } }
        }
        SC_BARRIER();
    }
#undef SC_LOAD
#undef SC_WRITE
}
__device__ __forceinline__ void scan_pass1(Frame& F) {
    if (F.vcu >= 208) return;
    const int head = F.vcu / 26, r = F.vcu % 26, lane = F.lane, w = F.wave, l15 = lane & 15, q4 = lane >> 4;
    int g, qd; bool mpart;
    if (r < 2) { g = 0; qd = r; mpart = false; } else { g = 1 + ((r - 2) >> 2); const int sub = (r - 2) & 3; mpart = sub < 2; qd = sub & 1; }
    const int col = 64 * qd + 16 * (w & 3) + l15;
    f32x4 S[8];
#pragma unroll
    for (int dt = 0; dt < 8; ++dt)
#pragma unroll
        for (int rg = 0; rg < 4; ++rg) S[dt][rg] = (mpart && (16 * dt + 4 * q4 + rg == col)) ? 1.f : 0.f;
    if (mpart) scan_steps<false, false>(F, head, g * SLEN, SLEN, 64 * qd, S); else scan_steps<true, false>(F, head, g * SLEN, SLEN, 64 * qd, S);
    if (w < 4) {
        if (mpart) { bf16* mg = (bf16*)(F.ws + WS_MG) + ((size_t)(head * SGRP + g) * 128) * 128 + col;
#pragma unroll
            for (int dt = 0; dt < 8; ++dt)
#pragma unroll
                for (int rg = 0; rg < 4; ++rg) mg[(16 * dt + 4 * q4 + rg) * 128] = (bf16)f2bf(S[dt][rg]); }
        else { float* bg = (float*)(F.ws + WS_BG) + ((size_t)(head * SGRP + g) * 128) * 128 + col;
#pragma unroll
            for (int dt = 0; dt < 8; ++dt)
#pragma unroll
                for (int rg = 0; rg < 4; ++rg) bg[(16 * dt + 4 * q4 + rg) * 128] = S[dt][rg]; }
    }
}
__device__ __forceinline__ void scan_pass2(Frame& F) {
    if (F.vcu >= 128) return;
    const int head = F.vcu >> 4, g = (F.vcu & 15) >> 1, qd = F.vcu & 1, lane = F.lane, w = F.wave, l15 = lane & 15, q4 = lane >> 4;
    const int col = 64 * qd + 16 * (w & 3) + l15;
    f32x4 S[8];
#pragma unroll
    for (int dt = 0; dt < 8; ++dt) S[dt] = (f32x4){0.f, 0.f, 0.f, 0.f};
    if (w < 4 && g > 0) {
        const float* bg0 = (const float*)(F.ws + WS_BG) + ((size_t)(head * SGRP) * 128) * 128 + col;
#pragma unroll
        for (int dt = 0; dt < 8; ++dt)
#pragma unroll
            for (int rg = 0; rg < 4; ++rg) S[dt][rg] = bg0[(16 * dt + 4 * q4 + rg) * 128];
#pragma unroll 1
        for (int j = 1; j < g; ++j) {
            const float* bg = (const float*)(F.ws + WS_BG) + ((size_t)(head * SGRP + j) * 128) * 128 + col;
            const bf16* mg = (const bf16*)(F.ws + WS_MG) + ((size_t)(head * SGRP + j) * 128) * 128 + 4 * q4;
            bf16x8 SB[4];
#pragma unroll
            for (int s = 0; s < 4; ++s) SB[s] = pack8f(S[2 * s], S[2 * s + 1]);
#pragma unroll
            for (int dt = 0; dt < 8; ++dt) { f32x4 acc;
#pragma unroll
                for (int rg = 0; rg < 4; ++rg) acc[rg] = bg[(16 * dt + 4 * q4 + rg) * 128];
#pragma unroll
                for (int s = 0; s < 4; ++s) { const bf16* mp = mg + (size_t)(16 * dt + l15) * 128 + 32 * s; const u32x2 a = *(const GAS u32x2*)mp, b = *(const GAS u32x2*)(mp + 16); acc = MFMA16(cat8(a, b), SB[s], acc); }
                S[dt] = acc; }
        }
    }
    scan_steps<true, true>(F, head, g * SLEN, SLEN, 64 * qd, S);
}

__device__ __forceinline__ void finalize_delta_phase(Frame& F) {
    bf16* OD = (bf16*)((unsigned char*)F.out + DO_OD); const bf16* Z = (const bf16*)((unsigned char*)F.out + DO_Z);
    const int gw = F.vcu * NWAVES + F.wave, NGW = F.G * NWAVES, lane = F.lane;
    const int dc = (lane & 7) * 16;
    f32x4 dn[4];
#pragma unroll
    for (int i = 0; i < 4; ++i) dn[i] = *(const GAS f32x4*)(F.dn_norm + dc + 4 * i);
    for (int row = gw; row < SEQ; row += NGW) {
        const v4u o0 = *(const GAS v4u*)(OD + (size_t)row * 1024 + lane * 16), o1 = *(const GAS v4u*)(OD + (size_t)row * 1024 + lane * 16 + 8);
        const v4u z0 = *(const GAS v4u*)(Z + (size_t)row * 1024 + lane * 16), z1 = *(const GAS v4u*)(Z + (size_t)row * 1024 + lane * 16 + 8);
        float o[16], z[16];
#pragma unroll
        for (int i = 0; i < 4; ++i) { o[2 * i] = bflo(o0[i]); o[2 * i + 1] = bfhi(o0[i]); o[8 + 2 * i] = bflo(o1[i]); o[8 + 2 * i + 1] = bfhi(o1[i]);
            z[2 * i] = bflo(z0[i]); z[2 * i + 1] = bfhi(z0[i]); z[8 + 2 * i] = bflo(z1[i]); z[8 + 2 * i + 1] = bfhi(z1[i]); }
        float ss = 0.f;
#pragma unroll
        for (int i = 0; i < 16; ++i) ss += o[i] * o[i];
        ss += __shfl_xor(ss, 1); ss += __shfl_xor(ss, 2); ss += __shfl_xor(ss, 4);
        const float rs = 1.0f / sqrtf(ss * (1.0f / 128.0f) + EPS);
        v4u w0, w1;
#pragma unroll
        for (int i = 0; i < 4; ++i) { w0[i] = cvtpk(o[2 * i] * rs * dn[i >> 1][(2 * i) & 3] * z[2 * i], o[2 * i + 1] * rs * dn[i >> 1][(2 * i + 1) & 3] * z[2 * i + 1]);
            w1[i] = cvtpk(o[8 + 2 * i] * rs * dn[2 + (i >> 1)][(2 * i) & 3] * z[8 + 2 * i], o[8 + 2 * i + 1] * rs * dn[2 + (i >> 1)][(2 * i + 1) & 3] * z[8 + 2 * i + 1]); }
        *(GAS v4u*)(OD + (size_t)row * 1024 + lane * 16) = w0; *(GAS v4u*)(OD + (size_t)row * 1024 + lane * 16 + 8) = w1;
    }
}

__device__ __forceinline__ void final_norm_phase(Frame& F) {
    const float* SSQ = (const float*)(F.ws + WS_SSQ2);
    const int gw = F.vcu * NWAVES + F.wave, NGW = F.G * NWAVES, lane = F.lane;
    f32x4 nf[4];
#pragma unroll
    for (int j = 0; j < 4; ++j) nf[j] = ((const GAS f32x4*)F.norm_final)[lane + 64 * j];
    for (int row = gw; row < SEQ; row += NGW) {
        const f32x4* sp = (const f32x4*)(SSQ + (size_t)row * 16); const f32x4 s0 = sp[0], s1 = sp[1], s2 = sp[2], s3 = sp[3];
        const float ss = ((s0[0] + s0[1]) + (s0[2] + s0[3])) + ((s1[0] + s1[1]) + (s1[2] + s1[3])) + ((s2[0] + s2[1]) + (s2[2] + s2[3])) + ((s3[0] + s3[1]) + (s3[2] + s3[3]));
        const float rs = 1.0f / sqrtf(ss * (1.0f / 1024.0f) + EPS);
        GAS f32x4* hr = (GAS f32x4*)(F.out + (size_t)row * DM) + lane;
#pragma unroll
        for (int j = 0; j < 4; ++j) { const f32x4 v = hr[64 * j]; hr[64 * j] = v * rs * nf[j]; }
    }
}

#define GEMM_PHASE(EPI, A_, B_, N_, K_, ...) do { pg8::Gemm g{(const bf16*)(A_), (const bf16*)(B_), SEQ, (N_), (K_)}; pg8::StaticOrder S; S.init(SEQ, (N_), F.G, (int)blockIdx.x); \
        pg8::EPI E{__VA_ARGS__}; pg8::gemm_phase<pg8::EPI, pg8::StaticOrder, true, true>(F.lds + RING_OFF, g, S, E); } while (0)
__device__ __forceinline__ void ph_gemm_qkva(Frame& F) {
    GEMM_PHASE(EpiStore, F.ws + WS_U, F.ws + WS_WIN, 4608, 1024, (bf16*)(F.ws + WS_QKVA), 4608); }
__device__ __forceinline__ void ph_gemm_qkvd(Frame& F) {
    GEMM_PHASE(EpiQkvd, F.ws + WS_U, (const bf16*)(F.ws + WS_WIN) + (size_t)4608 * 1024, 4096, 1024, (bf16*)(F.ws + WS_QKVD), (bf16*)(F.ws + WS_HALO), (bf16*)((unsigned char*)F.out + DO_Z)); }
__device__ __forceinline__ void ph_gemm_t1(Frame& F) {
    GEMM_PHASE(EpiStore, F.ws + WS_YA, F.ws + WS_WPA, 1024, 512, (bf16*)(F.ws + WS_T1), 1024); }
__device__ __forceinline__ void ph_gemm_t2(Frame& F) {
    GEMM_PHASE(EpiStore, (unsigned char*)F.out + DO_OD, F.ws + WS_WPD, 1024, 1024, (bf16*)(F.ws + WS_T2), 1024); }
__device__ __forceinline__ void ph_gemm_gate(Frame& F) {
    GEMM_PHASE(EpiGateMerge, F.ws + WS_U, (const bf16*)(F.ws + WS_WIN) + (size_t)8704 * 1024, 2048, 1024, (bf16*)(F.ws + WS_T1), (const bf16*)(F.ws + WS_T2)); }
__device__ __forceinline__ void ph_gemm_out(Frame& F) {
    GEMM_PHASE(EpiResid, F.ws + WS_T1, F.ws + WS_WOUT, 1024, 1024, F.x, F.out, (bf16*)(F.ws + WS_HB), (float*)(F.ws + WS_SSQ1)); }
__device__ __forceinline__ void ph_gemm_gu(Frame& F) {
    GEMM_PHASE(EpiSwiglu, F.ws + WS_HB, F.ws + WS_WGU, 5632, 1024, (bf16*)(F.ws + WS_ACT), (const float*)(F.ws + WS_SSQ1), EPS); }
__device__ __forceinline__ void ph_gemm_down(Frame& F) {
    GEMM_PHASE(EpiResid, F.ws + WS_ACT, F.ws + WS_WDN, 1024, 2816, F.out, F.out, nullptr, (float*)(F.ws + WS_SSQ2)); }

struct Args { const float* in[15]; float* out; unsigned char* ws; int ph_lo, ph_hi; };
__global__ void __launch_bounds__(NWAVES * 64, 2) hyb_fwd(Args args) {
    extern __shared__ __attribute__((aligned(16))) unsigned char lds[];
    Frame F;
    F.lds = (LAS unsigned char*)lds;
    F.MISC = (volatile LAS unsigned*)(F.lds + MISC_OFF);
    F.tid = threadIdx.x; F.lane = F.tid & 63; F.wave = __builtin_amdgcn_readfirstlane(F.tid >> 6);
    F.G = gridDim.x; { const int bx = blockIdx.x; F.vcu = (F.G % 8 == 0) ? (bx % 8) * (F.G / 8) + bx / 8 : bx; }
    unsigned char* ws = args.ws; F.ws = ws; F.out = args.out;
    F.ctl = (gu32*)(ws + WS_CTL);
    F.x = args.in[0]; F.norm_mix = args.in[1]; F.w_in = args.in[2]; F.conv_w = args.in[3]; F.a_log = args.in[4]; F.dt_bias = args.in[5]; F.dn_norm = args.in[6];
    F.w_pa = args.in[7]; F.w_pd = args.in[8]; F.w_out = args.in[9]; F.norm_ffn = args.in[10]; F.w_gate = args.in[11]; F.w_up = args.in[12]; F.w_down = args.in[13]; F.norm_final = args.in[14];
    for (int u = F.tid; u < (LDS_BYTES - LDSCTL_OFF) / 4; u += NWAVES * 64) ((LAS unsigned*)(F.lds + LDSCTL_OFF))[u] = 0u;
    __syncthreads();
    XcdBarrier bar; bar.bar = (unsigned*)(F.ctl + CW_BAR); bar.x = 0; bar.st = nullptr;
    if (!MK_SPLIT) bar = xcd_barrier_post((unsigned*)(F.ctl + CW_BAR), F.MISC + 8);
    const int lo = args.ph_lo, hi = args.ph_hi;
#ifdef ONLY_PH
#define IN(k) ((k) == ONLY_PH && lo <= (k) && (k) < hi)
#else
#define IN(k) (lo <= (k) && (k) < hi)
#endif
#define SEAM(k) do { if (IN(k) && IN((k) + 1)) xcd_barrier(bar); } while (0)
#ifndef REP_PH
#define REP_PH -1
#endif
#ifndef REP_N
#define REP_N 2
#endif
#define REPS(k) for (int rep_ = 0; rep_ < ((k) == REP_PH ? REP_N : 1); ++rep_)
#ifndef DUP_PH
#define DUP_PH -1
#endif
#define PHASE(k, CALL) do { if (IN(k)) { CALL; if (DUP_PH == (k)) { __syncthreads(); CALL; } } SEAM(k); } while (0)
    PHASE(0, p0_prologue(F));
    PHASE(1, ph_gemm_qkva(F));
    PHASE(2, attn_phase(F));
    PHASE(3, merge_phase(F));
    PHASE(4, ph_gemm_qkvd(F));
    PHASE(5, prep_phase(F));
    if (DUP_PH == 45) { xcd_barrier(bar); ph_gemm_qkvd(F); xcd_barrier(bar); prep_phase(F); xcd_barrier(bar); }
    PHASE(6, scan_pass1(F));
    PHASE(7, scan_pass2(F));
    PHASE(8, finalize_delta_phase(F));
    PHASE(9, ph_gemm_t1(F));
    PHASE(10, ph_gemm_t2(F));
    PHASE(11, ph_gemm_gate(F));
    PHASE(12, ph_gemm_out(F));
    PHASE(13, ph_gemm_gu(F));
    PHASE(14, ph_gemm_down(F));
    PHASE(15, final_norm_phase(F));
#undef IN
#undef SEAM
#undef PHASE
}

extern "C" void kernel_launch(void* const* d_in, const int* in_sizes, int n_in, void* d_out, int out_size, void* d_ws, size_t ws_size, hipStream_t stream) {
    static int grid = 0;
    if (grid == 0) {
        if (n_in != 15 || in_sizes[0] != SEQ * DM || out_size != SEQ * DM || ws_size < WS_END) { fprintf(stderr, "kernel_launch: unexpected shapes (n_in %d, in0 %d, out %d, ws %zu)\n", n_in, n_in > 0 ? in_sizes[0] : -1, out_size, ws_size); grid = -1; return; }
        int dev = 0, cus = 0, per_cu = 0;
        if (hipGetDevice(&dev) != hipSuccess || hipDeviceGetAttribute(&cus, hipDeviceAttributeMultiprocessorCount, dev) != hipSuccess) { grid = -1; return; }
        if (hipFuncSetAttribute((const void*)hyb_fwd, hipFuncAttributeMaxDynamicSharedMemorySize, LDS_BYTES) != hipSuccess) { fprintf(stderr, "kernel_launch: hipFuncSetAttribute failed\n"); grid = -1; return; }
        if (hipOccupancyMaxActiveBlocksPerMultiprocessor(&per_cu, (const void*)hyb_fwd, NWAVES * 64, LDS_BYTES) != hipSuccess || per_cu < 1) { fprintf(stderr, "kernel_launch: occupancy query says %d\n", per_cu); per_cu = 1; }
        (void)hipGetLastError();
        grid = cus;
    }
    if (grid < 0) return;
    (void)hipMemsetAsync((char*)d_ws + WS_CTL, 0, CTL_ZERO_BYTES, stream);
    Args a{};
    for (int i = 0; i < 15; ++i) a.in[i] = (const float*)d_in[i];
    a.out = (float*)d_out; a.ws = (unsigned char*)d_ws;
#if MK_SPLIT
    for (int p = 0; p < N_PHASES; ++p) { a.ph_lo = p; a.ph_hi = p + 1; hipLaunchKernelGGL(hyb_fwd, dim3(grid), dim3(NWAVES * 64), LDS_BYTES, stream, a); }
#else
    a.ph_lo = 0; a.ph_hi = N_PHASES; hipLaunchKernelGGL(hyb_fwd, dim3(grid), dim3(NWAVES * 64), LDS_BYTES, stream, a);
#endif
}
```

```cpp
#include <hip/hip_runtime.h>
#include <cstdio>
#include <cstdint>
namespace pg8 {
#define PG8_LAS __attribute__((address_space(3)))
typedef unsigned short bf16_t;
typedef short bf16x8 __attribute__((ext_vector_type(8)));
typedef float f32x4 __attribute__((ext_vector_type(4)));
typedef unsigned u32x4 __attribute__((ext_vector_type(4)));
constexpr int BM = 256, BK = 64, HALF = 128, HTB = HALF * BK * 2  , STAGE_BYTES = 8 * HTB, NXCD = 8, WGM = 8;

__host__ __device__ __forceinline__ int lds_byte(int r, int c) { const int st = (r >> 4) * 2 + (c >> 5), rr = r & 15, cc = c & 31, ob = rr * 64 + cc * 2; return st * 1024 + (ob ^ (((ob >> 9) & 1) << 5)); }
__host__ __device__ __forceinline__ void stage_rc(int b, int& R, int& C) { const int st = b / 1024, sb = b % 1024, swz = sb ^ (((sb >> 9) & 1) << 5); R = (st >> 1) * 16 + swz / 64; C = (st & 1) * 32 + (swz % 64) / 2; }
__host__ __device__ __forceinline__ int perm32(int rho) { const int n = rho >> 4, i = rho & 15; return 8 * (i >> 2) + 4 * n + (i & 3); }

struct Unit { int pm, pn; };
struct Gemm { const bf16_t* A; const bf16_t* Bt; int M, N, K; };

struct StaticOrder {
    int nM, nN, nwg, G, c;
    __host__ __device__ void init(int M, int N, int G_, int c_) { nM = M / BM; nN = N / BM; nwg = nM * nN; G = G_; c = c_; }
    __host__ __device__ bool next(int i, Unit& u) const {
        const long L = (long)i * G + c; if (L >= nwg) return false;
        int wgid = (int)L; { const int q = nwg / NXCD, r = nwg % NXCD, xcd = wgid % NXCD, off = wgid / NXCD; wgid = (xcd < r ? xcd * (q + 1) : r * (q + 1) + (xcd - r) * q) + off; }
        const int nig = WGM * nN, gid = wgid / nig, fm = gid * WGM, gsz = (nM - fm) < WGM ? (nM - fm) : WGM;
        u.pm = fm + ((wgid % nig) % gsz); u.pn = (wgid % nig) / gsz; return true;
    }
    __device__ __forceinline__ void a_ready(const Unit&) const {}
    __device__ __forceinline__ void done(const Unit&) const {}
};

__device__ __forceinline__ unsigned cvt_pk_bf16(float lo, float hi) { unsigned r; asm volatile("v_cvt_pk_bf16_f32 %0, %1, %2" : "=v"(r) : "v"(lo), "v"(hi)); return r; }
typedef float f32x2 __attribute__((ext_vector_type(2)));
typedef unsigned u32x2 __attribute__((ext_vector_type(2)));
typedef float f32x2c __attribute__((ext_vector_type(2))); typedef __bf16 bf16x2c __attribute__((ext_vector_type(2)));
__device__ __forceinline__ unsigned cvt2(float lo, float hi) { f32x2c v = {lo, hi}; bf16x2c b = __builtin_convertvector(v, bf16x2c); return __builtin_bit_cast(unsigned, b); }
__device__ __forceinline__ u32x4 pack8(const f32x4 a, const f32x4 b) { u32x4 w; w.x = cvt2(a[0], a[1]); w.y = cvt2(a[2], a[3]); w.z = cvt2(b[0], b[1]); w.w = cvt2(b[2], b[3]); return w; }
__device__ __forceinline__ float bf_lo(unsigned w) { return __uint_as_float(w << 16); }
__device__ __forceinline__ float bf_hi(unsigned w) { return __uint_as_float(w & 0xffff0000u); }
__device__ __forceinline__ float sigmoidf_(float x) { return 1.0f / (1.0f + __expf(-x)); }
__device__ __forceinline__ float siluf_(float x) { return x / (1.0f + __expf(-x)); }

struct EpiStore {
    static constexpr bool PERM = true, AFTER_DRAIN = false;
    bf16_t* O; int ldc;
    __device__ __forceinline__ void operator()(const f32x4 (&acc)[2][2][4][2], const Unit& u, int wr, int wc, int fr, int fq) const {
        const int row0 = u.pm * BM + wr * 64 + fr, col0 = u.pn * BM + wc * 32 + 8 * fq;
#pragma unroll
        for (int ai = 0; ai < 2; ++ai)
#pragma unroll
            for (int m = 0; m < 4; ++m) { bf16_t* rowp = O + (size_t)(row0 + ai * HALF + m * 16) * ldc + col0;
#pragma unroll
                for (int bj = 0; bj < 2; ++bj) *(u32x4*)(rowp + bj * HALF) = pack8(acc[ai][bj][m][0], acc[ai][bj][m][1]); }
    }
};
struct EpiQkvd {
    static constexpr bool PERM = true, AFTER_DRAIN = false;
    bf16_t* QKVD; bf16_t* HALO;
    __device__ __forceinline__ void operator()(const f32x4 (&acc)[2][2][4][2], const Unit& u, int wr, int wc, int fr, int fq) const {
        const int row0 = u.pm * BM + wr * 64 + fr;
        const int col0 = u.pn * BM + wc * 32 + 8 * fq;
#pragma unroll
        for (int ai = 0; ai < 2; ++ai)
#pragma unroll
            for (int m = 0; m < 4; ++m) { const int row = row0 + ai * HALF + m * 16; bf16_t* rowp = QKVD + (size_t)row * 3072 + col0;
                const int rc = row & 63;
#pragma unroll
                for (int bj = 0; bj < 2; ++bj) { const u32x4 w = pack8(acc[ai][bj][m][0], acc[ai][bj][m][1]); *(u32x4*)(rowp + bj * HALF) = w;
                    if (rc >= 61) *(u32x4*)(HALO + ((size_t)(row >> 6) * 3 + (rc - 61)) * 3072 + col0 + bj * HALF) = w; } }
    }
};
struct EpiSilu {
    static constexpr bool PERM = true, AFTER_DRAIN = false;
    bf16_t* O; int ldc;
    __device__ __forceinline__ void operator()(const f32x4 (&acc)[2][2][4][2], const Unit& u, int wr, int wc, int fr, int fq) const {
        const int row0 = u.pm * BM + wr * 64 + fr, col0 = u.pn * BM + wc * 32 + 8 * fq;
#pragma unroll
        for (int ai = 0; ai < 2; ++ai)
#pragma unroll
            for (int m = 0; m < 4; ++m) { bf16_t* rowp = O + (size_t)(row0 + ai * HALF + m * 16) * ldc + col0;
#pragma unroll
                for (int bj = 0; bj < 2; ++bj) { f32x4 a = acc[ai][bj][m][0], b = acc[ai][bj][m][1];
#pragma unroll
                    for (int i = 0; i < 4; ++i) { a[i] = siluf_(a[i]); b[i] = siluf_(b[i]); }
                    *(u32x4*)(rowp + bj * HALF) = pack8(a, b); } }
    }
};
struct EpiGateMerge {
    static constexpr bool PERM = true, AFTER_DRAIN = false;
    bf16_t* T1; const bf16_t* T2;
    __device__ __forceinline__ void operator()(const f32x4 (&acc)[2][2][4][2], const Unit& u, int wr, int wc, int fr, int fq) const {
        const int row0 = u.pm * BM + wr * 64 + fr, col0 = u.pn * HALF + wc * 32 + 8 * fq;
#pragma unroll
        for (int ai = 0; ai < 2; ++ai)
#pragma unroll
            for (int m = 0; m < 4; ++m) { const size_t off = (size_t)(row0 + ai * HALF + m * 16) * 1024 + col0;
                const u32x4 a = *(const u32x4*)(T1 + off), b = *(const u32x4*)(T2 + off);
                f32x4 o0, o1;
#pragma unroll
                for (int i = 0; i < 2; ++i) {
                    o0[2 * i]     = sigmoidf_(acc[ai][0][m][0][2 * i])     * bf_lo(a[i])     + sigmoidf_(acc[ai][1][m][0][2 * i])     * bf_lo(b[i]);
                    o0[2 * i + 1] = sigmoidf_(acc[ai][0][m][0][2 * i + 1]) * bf_hi(a[i])     + sigmoidf_(acc[ai][1][m][0][2 * i + 1]) * bf_hi(b[i]);
                    o1[2 * i]     = sigmoidf_(acc[ai][0][m][1][2 * i])     * bf_lo(a[2 + i]) + sigmoidf_(acc[ai][1][m][1][2 * i])     * bf_lo(b[2 + i]);
                    o1[2 * i + 1] = sigmoidf_(acc[ai][0][m][1][2 * i + 1]) * bf_hi(a[2 + i]) + sigmoidf_(acc[ai][1][m][1][2 * i + 1]) * bf_hi(b[2 + i]); }
                *(u32x4*)(T1 + off) = pack8(o0, o1); }
    }
};
struct EpiResid {
    static constexpr bool PERM = true, AFTER_DRAIN = false;
    const float* BASE; float* OUT; bf16_t* HB; float* SSQ;
    __device__ __forceinline__ void operator()(const f32x4 (&acc)[2][2][4][2], const Unit& u, int wr, int wc, int fr, int fq) const {
        const int row0 = u.pm * BM + wr * 64 + fr, col0 = u.pn * BM + wc * 32 + 8 * fq;
#pragma unroll
        for (int ai = 0; ai < 2; ++ai)
#pragma unroll
            for (int m = 0; m < 4; ++m) { const int row = row0 + ai * HALF + m * 16; const size_t off = (size_t)row * 1024 + col0; float ss = 0.f;
#pragma unroll
                for (int bj = 0; bj < 2; ++bj) {
                    const f32x4 b0 = *(const f32x4*)(BASE + off + bj * HALF), b1 = *(const f32x4*)(BASE + off + bj * HALF + 4);
                    const f32x4 h0 = b0 + acc[ai][bj][m][0], h1 = b1 + acc[ai][bj][m][1];
                    ss += (h0[0] * h0[0] + h0[1] * h0[1]) + (h0[2] * h0[2] + h0[3] * h0[3]) + (h1[0] * h1[0] + h1[1] * h1[1]) + (h1[2] * h1[2] + h1[3] * h1[3]);
                    *(f32x4*)(OUT + off + bj * HALF) = h0; *(f32x4*)(OUT + off + bj * HALF + 4) = h1;
                    if (HB) *(u32x4*)(HB + off + bj * HALF) = pack8(h0, h1); }
                ss += __shfl_xor(ss, 16); ss += __shfl_xor(ss, 32);
                if (fq == 0) SSQ[(size_t)row * 16 + u.pn * 4 + wc] = ss; }
    }
};
struct EpiSwiglu {
    static constexpr bool PERM = true, AFTER_DRAIN = false;
    bf16_t* ACT; const float* SSQ; float eps;
    __device__ __forceinline__ void operator()(const f32x4 (&acc)[2][2][4][2], const Unit& u, int wr, int wc, int fr, int fq) const {
        const int row0 = u.pm * BM + wr * 64 + fr, col0 = u.pn * HALF + wc * 32 + 8 * fq;
#pragma unroll
        for (int ai = 0; ai < 2; ++ai)
#pragma unroll
            for (int m = 0; m < 4; ++m) { const int row = row0 + ai * HALF + m * 16;
                const f32x4* sp = (const f32x4*)(SSQ + (size_t)row * 16); const f32x4 s0 = sp[0], s1 = sp[1], s2 = sp[2], s3 = sp[3];
                const float ss = ((s0[0] + s0[1]) + (s0[2] + s0[3])) + ((s1[0] + s1[1]) + (s1[2] + s1[3])) + ((s2[0] + s2[1]) + (s2[2] + s2[3])) + ((s3[0] + s3[1]) + (s3[2] + s3[3]));
                const float rs = 1.0f / sqrtf(ss * (1.0f / 1024.0f) + eps);
                f32x4 o0, o1;
#pragma unroll
                for (int i = 0; i < 4; ++i) { o0[i] = siluf_(acc[ai][0][m][0][i] * rs) * (acc[ai][1][m][0][i] * rs); o1[i] = siluf_(acc[ai][0][m][1][i] * rs) * (acc[ai][1][m][1][i] * rs); }
                *(u32x4*)(ACT + (size_t)row * 2816 + col0) = pack8(o0, o1); }
    }
};
template <class Epi, class Sched, bool ALIGN_EPI = false, bool SP2 = false>
__device__ __forceinline__ void gemm_phase(PG8_LAS unsigned char* lds, const Gemm g, const Sched& S, const Epi& E) {
    const int tid = threadIdx.x, wid = __builtin_amdgcn_readfirstlane(tid >> 6), lane = tid & 63, wr = wid >> 2, wc = wid & 3, fr = lane & 15, fq = lane >> 4;
    const int K = g.K, nt = K / BK;
    unsigned voffA[2], voffB[2];
#pragma unroll
    for (int i = 0; i < 2; ++i) { int R, C; stage_rc(tid * 16 + i * 8192, R, C); const int Rb = Epi::PERM ? ((R & ~31) + perm32(R & 31)) : R;
        voffA[i] = (unsigned)(R * K + C) * 2u; voffB[i] = (unsigned)(Rb * K + C) * 2u; }
    const size_t kstep = (size_t)(BK * 2);
    const size_t hstep = (size_t)HALF * K * 2;
    const size_t tstep = 2 * hstep;
    const unsigned ldsw = (unsigned)wid * 1024u;
    const int aoff = lds_byte(wr * 64 + fr, fq * 8), boff = lds_byte(wc * 32 + fr, fq * 8);
#define PG8_SA(b, h) (((b) * 2 + (h)) * HTB)
#define PG8_SB(b, h) ((4 + (b) * 2 + (h)) * HTB)
#define PG8_STAGE(bufoff, gbase, voff) do { _Pragma("unroll") for (int _i = 0; _i < 2; ++_i) \
        __builtin_amdgcn_global_load_lds((const unsigned*)((const char*)(gbase) + (voff)[_i]), (PG8_LAS unsigned*)(lds + (bufoff) + ldsw + _i * 8192), 16, 0, 0); } while (0)
#define PG8_LDA(dst, b, h) do { _Pragma("unroll") for (int m = 0; m < 4; ++m) _Pragma("unroll") for (int k = 0; k < 2; ++k) dst[m][k] = *(const PG8_LAS bf16x8*)(lds + PG8_SA(b, h) + aoff + m * 2048 + k * 1024); } while (0)
#define PG8_LDB(dst, b, h) do { _Pragma("unroll") for (int n = 0; n < 2; ++n) _Pragma("unroll") for (int k = 0; k < 2; ++k) dst[n][k] = *(const PG8_LAS bf16x8*)(lds + PG8_SB(b, h) + boff + n * 2048 + k * 1024); } while (0)
#define PG8_MMA(ai, bj, At, Bt) do { __builtin_amdgcn_s_setprio(1); _Pragma("unroll") for (int m = 0; m < 4; ++m) _Pragma("unroll") for (int n = 0; n < 2; ++n) _Pragma("unroll") for (int k = 0; k < 2; ++k) \
        acc[ai][bj][m][n] = __builtin_amdgcn_mfma_f32_16x16x32_bf16(Bt[n][k], At[m][k], acc[ai][bj][m][n], 0, 0, 0); __builtin_amdgcn_s_setprio(0); } while (0)
#define PG8_WAIT_V(n) asm volatile("s_waitcnt vmcnt(" #n ")" ::: "memory")
#define PG8_WAIT_L(n) asm volatile("s_waitcnt lgkmcnt(" #n ")" ::: "memory")
#define PG8_BAR __builtin_amdgcn_s_barrier()
#define PG8_SCHED __builtin_amdgcn_sched_barrier(0)
    Unit cur, nxt; int ui = 0;
    if (!S.next(0, cur)) return;
    f32x4 acc[2][2][4][2];
#pragma unroll
    for (int a = 0; a < 2; ++a)
#pragma unroll
        for (int b = 0; b < 2; ++b)
#pragma unroll
            for (int m = 0; m < 4; ++m)
#pragma unroll
                for (int n = 0; n < 2; ++n) acc[a][b][m][n] = (f32x4){0.f, 0.f, 0.f, 0.f};
    bf16x8 At[4][2], B0[2][2], B1[2][2];
    const char* cA = (const char*)g.A + (size_t)cur.pm * tstep; const char* cB = (const char*)g.Bt + (size_t)cur.pn * tstep;
    S.a_ready(cur);
    if constexpr (SP2) {
        PG8_STAGE(PG8_SB(0, 0), cB, voffB); PG8_STAGE(PG8_SB(0, 1), cB + hstep, voffB); PG8_STAGE(PG8_SA(0, 0), cA, voffA); PG8_STAGE(PG8_SA(0, 1), cA + hstep, voffA);
        if (wr == 1) PG8_BAR;
        PG8_WAIT_V(2); PG8_BAR;
        PG8_STAGE(PG8_SB(1, 0), cB + kstep, voffB); PG8_STAGE(PG8_SA(1, 0), cA + kstep, voffA); PG8_STAGE(PG8_SB(1, 1), cB + hstep + kstep, voffB);
        PG8_WAIT_V(6); PG8_BAR;
    } else {
        PG8_STAGE(PG8_SB(0, 0), cB, voffB); PG8_STAGE(PG8_SA(0, 0), cA, voffA); PG8_STAGE(PG8_SB(0, 1), cB + hstep, voffB); PG8_STAGE(PG8_SA(0, 1), cA + hstep, voffA);
        if (wr == 1) PG8_BAR;
        PG8_WAIT_V(4); PG8_BAR;
        PG8_STAGE(PG8_SB(1, 0), cB + kstep, voffB); PG8_STAGE(PG8_SA(1, 0), cA + kstep, voffA); PG8_STAGE(PG8_SB(1, 1), cB + hstep + kstep, voffB);
        PG8_WAIT_V(6); PG8_BAR;
    }
    for (;;) {
        const bool has_next = S.next(ui + 1, nxt);
        const char* nA = has_next ? (const char*)g.A + (size_t)nxt.pm * tstep : cA; const char* nB = has_next ? (const char*)g.Bt + (size_t)nxt.pn * tstep : cB;
        for (int t = 0; t < nt; t += 2) {
            const bool last = (t == nt - 2);
            const char* a1 = cA + (size_t)(t + 1) * kstep;
            const char* a2 = last ? nA : cA + (size_t)(t + 2) * kstep; const char* b2 = last ? nB : cB + (size_t)(t + 2) * kstep;
            const char* a3 = a2 + kstep; const char* b3 = b2 + kstep;
            if (last && has_next) S.a_ready(nxt);
            if constexpr (SP2) {
            PG8_LDB(B0, 0, 0); PG8_LDB(B1, 0, 1); PG8_SCHED; PG8_LDA(At, 0, 0); PG8_STAGE(PG8_SA(1, 1), a1 + hstep, voffA);
            PG8_WAIT_V(8); PG8_WAIT_L(0); PG8_BAR; PG8_MMA(0, 0, At, B0); PG8_MMA(0, 1, At, B1); PG8_BAR; PG8_SCHED;
            PG8_LDA(At, 0, 1); PG8_STAGE(PG8_SB(0, 0), b2, voffB); PG8_STAGE(PG8_SB(0, 1), b2 + hstep, voffB); PG8_STAGE(PG8_SA(0, 0), a2, voffA);
            PG8_WAIT_V(8); PG8_WAIT_L(0); PG8_BAR; PG8_MMA(1, 0, At, B0); PG8_MMA(1, 1, At, B1); PG8_BAR; PG8_SCHED;
            PG8_LDB(B0, 1, 0); PG8_LDB(B1, 1, 1); PG8_SCHED; PG8_LDA(At, 1, 0); PG8_STAGE(PG8_SA(0, 1), a2 + hstep, voffA);
            PG8_WAIT_V(8); PG8_WAIT_L(0); PG8_BAR; PG8_MMA(0, 0, At, B0); PG8_MMA(0, 1, At, B1); PG8_BAR; PG8_SCHED;
            PG8_LDA(At, 1, 1); PG8_STAGE(PG8_SB(1, 0), b3, voffB); PG8_STAGE(PG8_SB(1, 1), b3 + hstep, voffB); PG8_STAGE(PG8_SA(1, 0), a3, voffA);
            PG8_WAIT_V(8); PG8_WAIT_L(0); PG8_BAR; PG8_MMA(1, 0, At, B0); PG8_MMA(1, 1, At, B1); PG8_BAR; PG8_SCHED;
            } else {
            PG8_LDB(B0, 0, 0); PG8_SCHED; PG8_LDA(At, 0, 0); PG8_STAGE(PG8_SA(1, 1), a1 + hstep, voffA);
            PG8_WAIT_L(8); PG8_BAR; PG8_WAIT_L(0); PG8_MMA(0, 0, At, B0); PG8_BAR; PG8_SCHED;
            PG8_LDB(B1, 0, 1); PG8_STAGE(PG8_SB(0, 0), b2, voffB);
            PG8_BAR; PG8_WAIT_L(0); PG8_MMA(0, 1, At, B1); PG8_BAR;
            PG8_LDA(At, 0, 1); PG8_STAGE(PG8_SA(0, 0), a2, voffA);
            PG8_BAR; PG8_WAIT_L(0); PG8_MMA(1, 0, At, B0); PG8_BAR; PG8_SCHED;
            PG8_STAGE(PG8_SB(0, 1), b2 + hstep, voffB);
            PG8_WAIT_V(6); PG8_BAR; PG8_MMA(1, 1, At, B1); PG8_BAR;
            PG8_LDB(B0, 1, 0); PG8_SCHED; PG8_LDA(At, 1, 0); PG8_STAGE(PG8_SA(0, 1), a2 + hstep, voffA);
            PG8_WAIT_L(8); PG8_BAR; PG8_WAIT_L(0); PG8_MMA(0, 0, At, B0); PG8_BAR; PG8_SCHED;
            PG8_LDB(B1, 1, 1); PG8_STAGE(PG8_SB(1, 0), b3, voffB);
            PG8_BAR; PG8_WAIT_L(0); PG8_MMA(0, 1, At, B1); PG8_BAR;
            PG8_LDA(At, 1, 1); PG8_STAGE(PG8_SA(1, 0), a3, voffA);
            PG8_BAR; PG8_WAIT_L(0); PG8_MMA(1, 0, At, B0); PG8_BAR; PG8_SCHED;
            PG8_STAGE(PG8_SB(1, 1), b3 + hstep, voffB);
            PG8_WAIT_V(6); PG8_BAR; PG8_MMA(1, 1, At, B1); PG8_BAR;
            }
        }
        if constexpr (ALIGN_EPI) { if (wr == 0) PG8_BAR; }
        if constexpr (!Epi::AFTER_DRAIN) { E(acc, cur, wr, wc, fr, fq); S.done(cur); }
        if (!has_next) break;
#pragma unroll
        for (int a = 0; a < 2; ++a)
#pragma unroll
            for (int b = 0; b < 2; ++b)
#pragma unroll
                for (int m = 0; m < 4; ++m)
#pragma unroll
                    for (int n = 0; n < 2; ++n) acc[a][b][m][n] = (f32x4){0.f, 0.f, 0.f, 0.f};
        cur = nxt; cA = nA; cB = nB; ++ui;
        if constexpr (ALIGN_EPI) { if (wr == 1) PG8_BAR; }
    }
    PG8_WAIT_V(0);
    if constexpr (!ALIGN_EPI) { if (wr == 0) PG8_BAR; }
    PG8_BAR;
    if constexpr (Epi::AFTER_DRAIN) { E.fused(acc, cur, wr, wc, fr, fq, lds, wid, lane); S.done(cur); }
#undef PG8_SA
#undef PG8_SB
#undef PG8_STAGE
#undef PG8_LDA
#undef PG8_LDB
#undef PG8_MMA
#undef PG8_WAIT_V
#undef PG8_WAIT_L
#undef PG8_BAR
#undef PG8_SCHED
}
}
#define GAS __attribute__((address_space(1)))
#define LAS __attribute__((address_space(3)))
typedef unsigned short bf16;
typedef unsigned v4u __attribute__((ext_vector_type(4)));
typedef float f32x4 __attribute__((ext_vector_type(4)));
typedef short bf16x8 __attribute__((ext_vector_type(8)));
typedef GAS unsigned gu32;
typedef GAS unsigned long long gu64;
#define RLX_AGENT __ATOMIC_RELAXED, __HIP_MEMORY_SCOPE_AGENT
#define LDS_WAIT() asm volatile("s_waitcnt lgkmcnt(0)" ::: "memory")
#define VM_WAIT() asm volatile("s_waitcnt vmcnt(0)" ::: "memory")
__device__ __forceinline__ unsigned long long rt() { return __builtin_amdgcn_s_memrealtime(); }
__device__ __forceinline__ unsigned f2bf(float f) { unsigned u = __builtin_bit_cast(unsigned, f); return (u + 0x7fffu + ((u >> 16) & 1u)) >> 16; }
__device__ __forceinline__ unsigned pk2(float lo, float hi) { return f2bf(lo) | (f2bf(hi) << 16); }

#define XB_TMO      128
#define XB_XCNT(j)  (256  + 64 * (j))
#define XB_XSUB(j)  (1280 + 64 * (j))
#define XB_XGEN(j)  (2304 + 64 * (j))
#define XB_TOP      3328
#define XB_TOPGEN   3392
#define XCD_BAR_WORDS 3456
#define XB_SPIN_CAP (1u << 18)

__device__ __forceinline__ unsigned xb_ld(unsigned* p)              { return __hip_atomic_load(p, __ATOMIC_RELAXED, __HIP_MEMORY_SCOPE_AGENT); }
__device__ __forceinline__ unsigned xb_add(unsigned* p, unsigned v) { return __hip_atomic_fetch_add(p, v, __ATOMIC_RELAXED, __HIP_MEMORY_SCOPE_AGENT); }
__device__ __forceinline__ unsigned xb_xcc_id() { return (unsigned)__builtin_amdgcn_s_getreg((3 << 11) | 20) & 0xFu; }
#define XB_SPIN(cond, bar) do { unsigned _sp = 0; while (cond) { __builtin_amdgcn_s_sleep(1); \
    if ((++_sp & 255u) == 0u) { if (xb_ld(&(bar)[XB_TMO])) break; if (_sp > XB_SPIN_CAP) { atomicAdd(&(bar)[XB_TMO], 1u); break; } } } } while (0)

struct XcdBarrier {
    unsigned* bar; unsigned x;
    volatile LAS unsigned* st;
};

__device__ __forceinline__ XcdBarrier xcd_barrier_post(unsigned* bar, volatile LAS unsigned* st) {
    XcdBarrier b; b.bar = bar; b.x = xb_xcc_id(); b.st = st;
    if (threadIdx.x == 0) (void)xb_add(&bar[XB_XCNT(b.x)], 1u);
    return b;
}
__device__ __forceinline__ void xcd_barrier_complete(unsigned* bar, unsigned x, unsigned& nloc, unsigned& nx) {
    const unsigned G = gridDim.x * gridDim.y * gridDim.z;
    unsigned sum, cnt, mine, sp = 0u;
    for (;;) {
        sum = 0u; cnt = 0u; mine = 0u;
#pragma unroll
        for (unsigned j = 0; j < 16; ++j) { const unsigned c = xb_ld(&bar[XB_XCNT(j)]); sum += c; cnt += (c > 0u) ? 1u : 0u; mine = (j == x) ? c : mine; }
        if (sum == G) break;
        __builtin_amdgcn_s_sleep(1);
        if ((++sp & 255u) == 0u) { if (xb_ld(&bar[XB_TMO])) break; if (sp > XB_SPIN_CAP) { atomicAdd(&bar[XB_TMO], 1u); break; } }
    }
    nloc = mine > 0u ? mine : 1u; nx = cnt > 0u ? cnt : 1u;
}

__device__ __forceinline__ void xcd_barrier(const XcdBarrier& b) {
    asm volatile("s_waitcnt vmcnt(0)" ::: "memory");
    __syncthreads();
    if (threadIdx.x == 0) {
        unsigned* bar = b.bar;
        __builtin_amdgcn_s_waitcnt(0);
        unsigned nloc = b.st[0], nx = b.st[1];
        if (nloc == 0u) { xcd_barrier_complete(bar, b.x, nloc, nx); b.st[0] = nloc; b.st[1] = nx; }
        const unsigned old = xb_add(&bar[XB_XSUB(b.x)], 1u);
        const unsigned gen = old / nloc;
        if (old + 1u == (gen + 1u) * nloc) {
            __builtin_amdgcn_fence(__ATOMIC_RELEASE, "agent");
            asm volatile("s_waitcnt vmcnt(0)" ::: "memory");
            const unsigned og = xb_add(&bar[XB_TOP], 1u);
            const unsigned tg = og / nx;
            if (og + 1u == (tg + 1u) * nx) xb_add(&bar[XB_TOPGEN], 1u);
            else XB_SPIN(xb_ld(&bar[XB_TOPGEN]) == tg, bar);
            __builtin_amdgcn_fence(__ATOMIC_ACQUIRE, "agent");
            xb_add(&bar[XB_XGEN(b.x)], 1u);
            asm volatile("s_waitcnt vmcnt(0)" ::: "memory");
        } else {
            XB_SPIN(xb_ld(&bar[XB_XGEN(b.x)]) == gen, bar);
            __builtin_amdgcn_fence(__ATOMIC_ACQUIRE, "agent");
            asm volatile("s_waitcnt vmcnt(0)" ::: "memory");
        }
    }
    __syncthreads();
}

constexpr int NWAVES = 8;
constexpr int SEQ = 16384, DM = 1024, DFF = 2816, DIN = 10768;
constexpr float EPS = 1e-6f;
constexpr float LOG2E = 1.4426950408889634f, LN2 = 0.6931471805599453f;
#ifndef MK_SPLIT
#define MK_SPLIT 0
#endif
constexpr int N_PHASES = 16;

constexpr size_t MiB = 1u << 20;
constexpr size_t WS_CTL = 0, CTL_ZERO_BYTES = 64 * 1024;
constexpr size_t WS_WIN = 2 * MiB;
constexpr size_t WS_WPA = 23 * MiB;
constexpr size_t WS_WPD = 24 * MiB;
constexpr size_t WS_WOUT = 26 * MiB;
constexpr size_t WS_WGU = 28 * MiB;
constexpr size_t WS_WDN = 39 * MiB;
constexpr size_t WS_BETA = 45 * MiB;
constexpr size_t WS_G = WS_BETA + MiB / 2;
constexpr size_t WS_LSE = 46 * MiB;
constexpr size_t WS_GC = 47 * MiB;
constexpr size_t WS_SSQ1 = 48 * MiB;
constexpr size_t WS_SSQ2 = 49 * MiB;
constexpr size_t WS_HALO = 50 * MiB;
constexpr size_t WS_U = 56 * MiB;
constexpr size_t WS_R = 88 * MiB;
constexpr size_t WS_QKVA = WS_R;
constexpr size_t WS_YA = 232 * MiB;
constexpr size_t WS_QKVD = WS_R;
constexpr size_t WS_TQ = 184 * MiB;
constexpr size_t WS_QK = 200 * MiB;
constexpr size_t WS_T1 = 88 * MiB;
constexpr size_t WS_T2 = 120 * MiB;
constexpr size_t WS_HB = 184 * MiB;
constexpr size_t WS_ACT = 88 * MiB;
constexpr size_t WS_END = 256 * MiB;
constexpr size_t DO_OG = 0, DO_Z = 0, DO_OD = 32 * MiB;
constexpr int CW_BAR = 4096;

constexpr int RING_OFF = 0, RING_BYTES = 155648;
constexpr int LDSCTL_OFF = RING_BYTES, MISC_OFF = LDSCTL_OFF + 320;
constexpr int LDS_BYTES = 159744;
static_assert(MISC_OFF + 128 <= LDS_BYTES, "LDS map");

typedef unsigned u32x2 __attribute__((ext_vector_type(2)));
typedef short v4i16_t __attribute__((ext_vector_type(4)));
#define MFMA16(a, b, c) __builtin_amdgcn_mfma_f32_16x16x32_bf16((a), (b), (c), 0, 0, 0)
typedef float f32x2_t __attribute__((ext_vector_type(2))); typedef __bf16 bf16x2_t __attribute__((ext_vector_type(2)));
__device__ __forceinline__ unsigned cvtpk(float lo, float hi) { f32x2_t v = {lo, hi}; bf16x2_t b = __builtin_convertvector(v, bf16x2_t); return __builtin_bit_cast(unsigned, b); }
__device__ __forceinline__ bf16x8 pack8f(const f32x4 a, const f32x4 b) { v4u w; w.x = cvtpk(a[0], a[1]); w.y = cvtpk(a[2], a[3]); w.z = cvtpk(b[0], b[1]); w.w = cvtpk(b[2], b[3]); return __builtin_bit_cast(bf16x8, w); }
__device__ __forceinline__ float bflo(unsigned w) { return __uint_as_float(w << 16); }
__device__ __forceinline__ float bfhi(unsigned w) { return __uint_as_float(w & 0xffff0000u); }
__device__ __forceinline__ u32x2 tr16(const LAS unsigned char* p) { return __builtin_bit_cast(u32x2, __builtin_amdgcn_ds_read_tr16_b64_v4i16((LAS v4i16_t*)p)); }
__device__ __forceinline__ bf16x8 cat8(u32x2 lo, u32x2 hi) { v4u w; w.x = lo.x; w.y = lo.y; w.z = hi.x; w.w = hi.y; return __builtin_bit_cast(bf16x8, w); }
template <int CTRL> __device__ __forceinline__ float dpp_f(float x) { return __int_as_float(__builtin_amdgcn_update_dpp(0, __float_as_int(x), CTRL, 0xf, 0xf, false)); }
__device__ __forceinline__ float wave_sum(float v) {
#pragma unroll
    for (int o = 1; o < 64; o <<= 1) v += __shfl_xor(v, o);
    return v;
}

struct Frame {
    LAS unsigned char* lds;
    volatile LAS unsigned* MISC;
    gu32* ctl;
    int tid, lane, wave;
    int vcu, G;
    const float *x, *norm_mix, *w_in, *conv_w, *a_log, *dt_bias, *dn_norm, *w_pa, *w_pd, *w_out, *norm_ffn, *w_gate, *w_up, *w_down, *norm_final;
    float* out; unsigned char* ws;
};

__device__ __forceinline__ void tr_item(const float* W, int ldw, int k0, int nsrc, bf16* WT, int Kd, int drow, const float* kscale, LAS float* scr, int lane) {
#pragma unroll
    for (int i = 0; i < 32; ++i) { const int kk = 2 * i + (lane >> 5); float v = W[(size_t)(k0 + kk) * ldw + nsrc + (lane & 31)]; if (kscale) v *= kscale[k0 + kk]; scr[kk * 33 + (lane & 31)] = v; }
    LDS_WAIT(); asm volatile("" ::: "memory");
    const int c = lane & 7;
#pragma unroll
    for (int j = 0; j < 4; ++j) { const int n = (lane >> 3) + 8 * j; const LAS float* s = scr + (8 * c) * 33 + n;
        v4u o; o.x = pk2(s[0 * 33], s[1 * 33]); o.y = pk2(s[2 * 33], s[3 * 33]); o.z = pk2(s[4 * 33], s[5 * 33]); o.w = pk2(s[6 * 33], s[7 * 33]);
        *(GAS v4u*)(WT + (size_t)(drow + n) * Kd + k0 + 8 * c) = o; }
    LDS_WAIT(); asm volatile("" ::: "memory");
}
__device__ __forceinline__ void p0_prologue(Frame& F) {
    LAS float* scr = (LAS float*)(F.lds + RING_OFF + F.wave * 16384);
    const int gw = F.vcu * NWAVES + F.wave, NGW = F.G * NWAVES;
    bf16* WIN = (bf16*)(F.ws + WS_WIN);
    constexpr int I0 = 16 * 272, I1 = 16 * 64;
    constexpr int NITEMS = I0 + I1;
    for (int it = gw; it < NITEMS; it += NGW) {
        int r = it;
        if (r < I0) { const int kb = r / 272, nb = r % 272; tr_item(F.w_in, DIN, 64 * kb, 32 * nb, WIN, 1024, 32 * nb, nullptr, scr, F.lane); continue; } r -= I0;
        { const int kb = r / 64, nb = r % 64, j0 = 32 * nb, which = j0 >> 10, jj = j0 & 1023;
            tr_item(F.w_in, DIN, 64 * kb, 8720 + j0, WIN, 1024, 8704 + 256 * (jj >> 7) + 128 * which + (jj & 127), nullptr, scr, F.lane); }
    }
    __syncthreads();
    LAS float* wba = (LAS float*)(F.lds + RING_OFF);
    { f32x4 wv[8];
#pragma unroll
        for (int i = 0; i < 8; ++i) { const int id = F.tid + 512 * i, k = id >> 2, c4 = id & 3; wv[i] = *(const GAS f32x4*)(F.w_in + (size_t)k * DIN + 8704 + 4 * c4); }
#pragma unroll
        for (int i = 0; i < 8; ++i) { const int id = F.tid + 512 * i, k = id >> 2, c4 = id & 3; const int ln = (k & 255) >> 2, ii = k & 3, j = k >> 8;
            *(LAS f32x4*)(wba + ((((j * 4 + ii) * 4 + c4) * 64 + ln) << 2)) = wv[i]; } }
    __syncthreads();
    bf16* U = (bf16*)(F.ws + WS_U); float* BETA = (float*)(F.ws + WS_BETA); float* GG = (float*)(F.ws + WS_G);
    f32x4 vn[4];
    if (gw < SEQ) {
#pragma unroll
        for (int j = 0; j < 4; ++j) vn[j] = ((const GAS f32x4*)(F.x + (size_t)gw * DM) + F.lane)[64 * j]; }
    for (int m = gw; m < SEQ; m += NGW) {
        asm volatile("" ::: "memory");
        f32x4 v[4]; float s = 0.f;
#pragma unroll
        for (int j = 0; j < 4; ++j) { v[j] = vn[j]; s += (v[j].x * v[j].x + v[j].y * v[j].y) + (v[j].z * v[j].z + v[j].w * v[j].w); }
        if (m + NGW < SEQ) {
#pragma unroll
            for (int j = 0; j < 4; ++j) vn[j] = ((const GAS f32x4*)(F.x + (size_t)(m + NGW) * DM) + F.lane)[64 * j]; }
        const float rstd = 1.0f / sqrtf(wave_sum(s) * (1.f / DM) + EPS);
        GAS unsigned long long* o8 = (GAS unsigned long long*)(U + (size_t)m * DM) + F.lane;
        float acc[16];
#pragma unroll
        for (int c = 0; c < 16; ++c) acc[c] = 0.f;
#pragma unroll
        for (int j = 0; j < 4; ++j) { const f32x4 nm = ((const GAS f32x4*)F.norm_mix)[F.lane + 64 * j]; v[j] = v[j] * rstd * nm;
            o8[64 * j] = (unsigned long long)cvtpk(v[j].x, v[j].y) | ((unsigned long long)cvtpk(v[j].z, v[j].w) << 32);
#pragma unroll
            for (int i = 0; i < 4; ++i)
#pragma unroll
                for (int c4 = 0; c4 < 4; ++c4) { const f32x4 w = *(const LAS f32x4*)(wba + ((((j * 4 + i) * 4 + c4) * 64 + F.lane) << 2));
                    acc[4 * c4 + 0] += v[j][i] * w[0]; acc[4 * c4 + 1] += v[j][i] * w[1]; acc[4 * c4 + 2] += v[j][i] * w[2]; acc[4 * c4 + 3] += v[j][i] * w[3]; } }
        const bool b5 = (F.lane & 32) != 0, b4 = (F.lane & 16) != 0, b3 = (F.lane & 8) != 0, b2 = (F.lane & 4) != 0;
        float r8[8], r4[4], r2[2];
#pragma unroll
        for (int c = 0; c < 8; ++c) { const float keep = b5 ? acc[c + 8] : acc[c], send = b5 ? acc[c] : acc[c + 8]; r8[c] = keep + __shfl_xor(send, 32); }
#pragma unroll
        for (int c = 0; c < 4; ++c) { const float keep = b4 ? r8[c + 4] : r8[c], send = b4 ? r8[c] : r8[c + 4]; r4[c] = keep + __shfl_xor(send, 16); }
#pragma unroll
        for (int c = 0; c < 2; ++c) { const float keep = b3 ? r4[c + 2] : r4[c], send = b3 ? r4[c] : r4[c + 2]; r2[c] = keep + dpp_f<0x140>(send); }
        float mine; { const float keep = b2 ? r2[1] : r2[0], send = b2 ? r2[0] : r2[1]; mine = keep + dpp_f<0x141>(send); }
        mine += dpp_f<0x4E>(mine); mine += dpp_f<0xB1>(mine);
        const int idx = F.lane >> 2;
        if ((F.lane & 3) == 0) {
            if (idx < 8) BETA[(size_t)m * 8 + idx] = 1.0f / (1.0f + expf(-mine));
            else { const int hh = idx - 8; const float xx = mine + F.dt_bias[hh]; const float sp = fmaxf(xx, 0.f) + log1pf(expf(-fabsf(xx))); GG[(size_t)m * 8 + hh] = -expf(F.a_log[hh]) * sp; } }
    }
}

template <int SET  >
__device__ __forceinline__ void p0_late_weights(Frame& F, const int gw, const int NGW) {
    LAS float* scr = (LAS float*)(F.lds + RING_OFF + F.wave * 16384);
    bf16* WPA = (bf16*)(F.ws + WS_WPA); bf16* WPD = (bf16*)(F.ws + WS_WPD); bf16* WOUT = (bf16*)(F.ws + WS_WOUT); bf16* WGU = (bf16*)(F.ws + WS_WGU); bf16* WDN = (bf16*)(F.ws + WS_WDN);
    constexpr int I2 = 8 * 32, I3 = 16 * 32, I4 = 16 * 32, I5 = 16 * 88, I6 = 16 * 88, I7 = 44 * 32;
    if (SET == 0) {
        for (int it = gw; it < I2 + I3 + I4 + I7; it += NGW) {
            int r = it;
            if (r < I2) { const int kb = r / 32, nb = r % 32; tr_item(F.w_pa, 1024, 64 * kb, 32 * nb, WPA, 512, 32 * nb, nullptr, scr, F.lane); continue; } r -= I2;
            if (r < I3) { const int kb = r / 32, nb = r % 32; tr_item(F.w_pd, 1024, 64 * kb, 32 * nb, WPD, 1024, 32 * nb, nullptr, scr, F.lane); continue; } r -= I3;
            if (r < I4) { const int kb = r / 32, nb = r % 32; tr_item(F.w_out, 1024, 64 * kb, 32 * nb, WOUT, 1024, 32 * nb, nullptr, scr, F.lane); continue; } r -= I4;
            { const int kb = r / 32, nb = r % 32; tr_item(F.w_down, 1024, 64 * kb, 32 * nb, WDN, DFF, 32 * nb, nullptr, scr, F.lane); }
        }
    } else {
        for (int it = gw; it < I5 + I6; it += NGW) {
            int r = it;
            if (r < I5) { const int kb = r / 88, nb = r % 88, j0 = 32 * nb; tr_item(F.w_gate, DFF, 64 * kb, j0, WGU, 1024, 256 * (j0 >> 7) + (j0 & 127), F.norm_ffn, scr, F.lane); continue; } r -= I5;
            { const int kb = r / 88, nb = r % 88, j0 = 32 * nb; tr_item(F.w_up, DFF, 64 * kb, j0, WGU, 1024, 256 * (j0 >> 7) + 128 + (j0 & 127), F.norm_ffn, scr, F.lane); }
        }
    }
}

__device__ __forceinline__ void attn_phase(Frame& F) {
    const bf16* QKV = (const bf16*)(F.ws + WS_QKVA);
    bf16* OG = (bf16*)((unsigned char*)F.out + DO_OG); float* LSE = (float*)(F.ws + WS_LSE);
    LAS unsigned char* Ks = F.lds + RING_OFF; LAS unsigned char* Vs = Ks + 256 * 272;
    const int lane = F.lane, w = F.wave, l15 = lane & 15, q4 = lane >> 4;
    for (int unit = F.vcu; unit < 12 * 128; unit += F.G) {
        const int h = unit >> 7, tau = unit & 127, gi = h >> 2, hh = h & 3, sh = 2 * gi, d = 1 << sh, r = tau & (d - 1), n = tau >> sh;
        { const int key = F.tid >> 1, half = F.tid & 1; const int sidx = (n - 1) * 128 + key;
            v4u kv[8], vv[8];
            if (sidx >= 0) { const size_t pos = (size_t)sidx * d + r;
                const GAS v4u* kp = (const GAS v4u*)(QKV + pos * 4608 + 1536 + h * 128 + half * 64); const GAS v4u* vp = (const GAS v4u*)(QKV + pos * 4608 + 3072 + h * 128 + half * 64);
#pragma unroll
                for (int i = 0; i < 8; ++i) { kv[i] = kp[i]; vv[i] = vp[i]; } }
            else {
#pragma unroll
                for (int i = 0; i < 8; ++i) { kv[i] = (v4u){0u, 0u, 0u, 0u}; vv[i] = (v4u){0u, 0u, 0u, 0u}; } }
#pragma unroll
            for (int i = 0; i < 8; ++i) { *(LAS v4u*)(Ks + key * 272 + half * 128 + i * 16) = kv[i]; *(LAS v4u*)(Vs + key * 288 + half * 128 + i * 16) = vv[i]; } }
        const int iq = 16 * w + l15; const size_t posq = (size_t)(n * 128 + iq) * d + r;
        bf16x8 qf[4];
#pragma unroll
        for (int ks = 0; ks < 4; ++ks) qf[ks] = *(const GAS bf16x8*)(QKV + posq * 4608 + h * 128 + 32 * ks + 8 * q4);
        __syncthreads();
        f32x4 sacc[9];
#pragma unroll
        for (int t = 0; t < 9; ++t) { sacc[t] = (f32x4){0.f, 0.f, 0.f, 0.f}; const LAS unsigned char* kp = Ks + (16 * (w + t) + l15) * 272 + 16 * q4;
#pragma unroll
            for (int ks = 0; ks < 4; ++ks) { const bf16x8 a = *(const LAS bf16x8*)(kp + 64 * ks); sacc[t] = MFMA16(a, qf[ks], sacc[t]); } }
        const float slope = exp2f(-8.0f * (float)(h + 1) / 12.0f);
        const float c1 = 0.08838834764831845f * LOG2E, c2 = slope * (float)d * LOG2E;
        float mx = -INFINITY;
#pragma unroll
        for (int t = 0; t < 9; ++t)
#pragma unroll
            for (int rg = 0; rg < 4; ++rg) { const int delta = 128 + l15 - 16 * t - 4 * q4 - rg; const int j = 16 * (w + t) + 4 * q4 + rg;
                const bool valid = (delta >= 0) && (delta <= 128) && (n > 0 || j >= 128);
                const float s = valid ? (sacc[t][rg] * c1 - c2 * (float)delta) : -INFINITY; sacc[t][rg] = s; mx = fmaxf(mx, s); }
        mx = fmaxf(mx, __shfl_xor(mx, 16)); mx = fmaxf(mx, __shfl_xor(mx, 32));
        float den = 0.f;
#pragma unroll
        for (int t = 0; t < 9; ++t)
#pragma unroll
            for (int rg = 0; rg < 4; ++rg) { const float p = exp2f(sacc[t][rg] - mx); den += p; sacc[t][rg] = p; }
        den += __shfl_xor(den, 16); den += __shfl_xor(den, 32);
        f32x4 oacc[8];
#pragma unroll
        for (int mt = 0; mt < 8; ++mt) oacc[mt] = (f32x4){0.f, 0.f, 0.f, 0.f};
#pragma unroll
        for (int u = 0; u < 5; ++u) { const bf16x8 pk = pack8f(sacc[2 * u], (u < 4) ? sacc[(u < 4) ? 2 * u + 1 : 0] : (f32x4){0.f, 0.f, 0.f, 0.f});
            const int kt0 = w + 2 * u, kt1 = (w + 2 * u + 1 < 16) ? w + 2 * u + 1 : 15;
            const LAS unsigned char* v0p = Vs + (16 * kt0 + 4 * q4 + (l15 >> 2)) * 288 + 8 * (l15 & 3); const LAS unsigned char* v1p = Vs + (16 * kt1 + 4 * q4 + (l15 >> 2)) * 288 + 8 * (l15 & 3);
#pragma unroll
            for (int mt = 0; mt < 8; ++mt) { const bf16x8 a = cat8(tr16(v0p + 32 * mt), tr16(v1p + 32 * mt)); oacc[mt] = MFMA16(a, pk, oacc[mt]); } }
        const float inv = 1.0f / den;
        bf16* op = OG + ((size_t)gi * SEQ + posq) * 512 + hh * 128 + 4 * q4;
#pragma unroll
        for (int mt = 0; mt < 8; ++mt) { u32x2 wv; wv.x = cvtpk(oacc[mt][0] * inv, oacc[mt][1] * inv); wv.y = cvtpk(oacc[mt][2] * inv, oacc[mt][3] * inv); *(GAS u32x2*)(op + 16 * mt) = wv; }
        if (q4 == 0) LSE[((size_t)gi * SEQ + posq) * 4 + hh] = (mx + log2f(den)) * LN2;
        __syncthreads();
    }
}

__device__ __forceinline__ void merge_phase(Frame& F) {
    const bf16* OG = (const bf16*)((unsigned char*)F.out + DO_OG); const float* LSE = (const float*)(F.ws + WS_LSE); bf16* YA = (bf16*)(F.ws + WS_YA);
    const int gw = F.vcu * NWAVES + F.wave, NGW = F.G * NWAVES, hh = F.lane >> 4;
    for (int p = gw; p < SEQ; p += NGW) {
        const float l0 = LSE[((size_t)0 * SEQ + p) * 4 + hh], l1 = LSE[((size_t)1 * SEQ + p) * 4 + hh], l2 = LSE[((size_t)2 * SEQ + p) * 4 + hh];
        const float m = fmaxf(l0, fmaxf(l1, l2)); float w0 = expf(l0 - m), w1 = expf(l1 - m), w2 = expf(l2 - m); const float inv = 1.0f / (w0 + w1 + w2); w0 *= inv; w1 *= inv; w2 *= inv;
        const v4u a = *(const GAS v4u*)(OG + ((size_t)0 * SEQ + p) * 512 + F.lane * 8), b = *(const GAS v4u*)(OG + ((size_t)1 * SEQ + p) * 512 + F.lane * 8), c = *(const GAS v4u*)(OG + ((size_t)2 * SEQ + p) * 512 + F.lane * 8);
        v4u o;
#pragma unroll
        for (int i = 0; i < 4; ++i) o[i] = cvtpk(w0 * bflo(a[i]) + w1 * bflo(b[i]) + w2 * bflo(c[i]), w0 * bfhi(a[i]) + w1 * bfhi(b[i]) + w2 * bfhi(c[i]));
        *(GAS v4u*)(YA + (size_t)p * 512 + F.lane * 8) = o;
    }
}

__device__ __forceinline__ void prep_phase(Frame& F) {
    bf16* QKVD = (bf16*)(F.ws + WS_QKVD); const bf16* HALO = (const bf16*)(F.ws + WS_HALO);
    const float* BETA = (const float*)(F.ws + WS_BETA); const float* GG = (const float*)(F.ws + WS_G); float* GC = (float*)(F.ws + WS_GC);
    bf16* TQ = (bf16*)(F.ws + WS_TQ); bf16* QK = (bf16*)(F.ws + WS_QK);
    const int gw = F.vcu * NWAVES + F.wave, NGW = F.G * NWAVES, lane = F.lane, l15 = lane & 15, q4 = lane >> 4;
    LAS float* A = (LAS float*)(F.lds + RING_OFF + F.wave * 16896); LAS float* gcs = A + 4096; LAS float* bts = gcs + 64;
    for (int task = gw; task < 2048; task += NGW) {
        const int n = task >> 3, h = task & 7;
        { float gv = GG[(size_t)(64 * n + lane) * 8 + h];
#pragma unroll
            for (int off = 1; off < 64; off <<= 1) { const float t = __shfl_up(gv, off); if (lane >= off) gv += t; }
            gcs[lane] = gv; bts[lane] = BETA[(size_t)(64 * n + lane) * 8 + h]; GC[(size_t)task * 64 + lane] = gv; }
        v4u xr[1][19];
#define PREP_LOAD(buf_, sg_) do { const int col_ = (sg_) * 1024 + h * 128 + 8 * l15; const bf16* base_ = QKVD + (size_t)(64 * n + 16 * q4) * 3072 + col_; \
            if (q4 > 0) { _Pragma("unroll") for (int j_ = 0; j_ < 3; ++j_) xr[buf_][j_] = *(const GAS v4u*)(base_ - (size_t)(3 - j_) * 3072); } \
            else if (n > 0) { _Pragma("unroll") for (int j_ = 0; j_ < 3; ++j_) xr[buf_][j_] = *(const GAS v4u*)(HALO + ((size_t)(n - 1) * 3 + j_) * 3072 + col_); } \
            else { xr[buf_][0] = xr[buf_][1] = xr[buf_][2] = (v4u){0u, 0u, 0u, 0u}; } \
            _Pragma("unroll") for (int t_ = 0; t_ < 16; ++t_) xr[buf_][3 + t_] = *(const GAS v4u*)(base_ + (size_t)t_ * 3072); } while (0)
#pragma unroll 1
        for (int sg = 0; sg < 3; ++sg) {
            PREP_LOAD(0, sg);
            asm volatile("s_waitcnt vmcnt(0)" ::: "memory");
            const int col = sg * 1024 + h * 128 + 8 * l15;
            f32x4 wlo[4], whi[4];
#pragma unroll
            for (int j = 0; j < 4; ++j) { wlo[j] = *(const GAS f32x4*)(F.conv_w + (size_t)j * 3072 + col); whi[j] = *(const GAS f32x4*)(F.conv_w + (size_t)j * 3072 + col + 4); }
            bf16* base = QKVD + (size_t)(64 * n + 16 * q4) * 3072 + col;
            const float sc = (sg == 0) ? 0.08838834764831845f : 1.0f;
#pragma unroll
            for (int t = 0; t < 16; ++t) {
                const v4u x0 = xr[0][t], x1 = xr[0][t + 1], x2 = xr[0][t + 2], x3 = xr[0][t + 3];
                float y[8];
#pragma unroll
                for (int e = 0; e < 4; ++e) {
                    const int c0 = 2 * e, c1 = 2 * e + 1;
                    const float w00 = (c0 < 4) ? wlo[0][c0 & 3] : whi[0][c0 & 3], w01 = (c0 < 4) ? wlo[1][c0 & 3] : whi[1][c0 & 3], w02 = (c0 < 4) ? wlo[2][c0 & 3] : whi[2][c0 & 3], w03 = (c0 < 4) ? wlo[3][c0 & 3] : whi[3][c0 & 3];
                    const float w10 = (c1 < 4) ? wlo[0][c1 & 3] : whi[0][c1 & 3], w11 = (c1 < 4) ? wlo[1][c1 & 3] : whi[1][c1 & 3], w12 = (c1 < 4) ? wlo[2][c1 & 3] : whi[2][c1 & 3], w13 = (c1 < 4) ? wlo[3][c1 & 3] : whi[3][c1 & 3];
                    float ya = w00 * bflo(x0[e]) + w01 * bflo(x1[e]) + w02 * bflo(x2[e]) + w03 * bflo(x3[e]), yb = w10 * bfhi(x0[e]) + w11 * bfhi(x1[e]) + w12 * bfhi(x2[e]) + w13 * bfhi(x3[e]);
                    y[c0] = ya / (1.0f + __expf(-ya)); y[c1] = yb / (1.0f + __expf(-yb)); }
                float rs = 1.0f;
                if (sg != 2) { float ss = 0.f;
#pragma unroll
                    for (int e = 0; e < 8; ++e) ss += y[e] * y[e];
                    ss += dpp_f<0xB1>(ss); ss += dpp_f<0x4E>(ss); ss += dpp_f<0x141>(ss); ss += dpp_f<0x140>(ss);
                    rs = sc / sqrtf(ss + EPS); }
                v4u st; st.x = cvtpk(y[0] * rs, y[1] * rs); st.y = cvtpk(y[2] * rs, y[3] * rs); st.z = cvtpk(y[4] * rs, y[5] * rs); st.w = cvtpk(y[6] * rs, y[7] * rs);
                *(GAS v4u*)(base + (size_t)t * 3072) = st; } }
#undef PREP_LOAD
        asm volatile("s_waitcnt vmcnt(0) lgkmcnt(0)" ::: "memory");
        bf16x8 kf[4][4], qfa[4][4];
        const bf16* rp0 = QKVD + (size_t)(64 * n + l15) * 3072 + h * 128 + 8 * q4;
#pragma unroll
        for (int mt = 0; mt < 4; ++mt)
#pragma unroll
            for (int ks = 0; ks < 4; ++ks) { kf[mt][ks] = *(const GAS bf16x8*)(rp0 + (size_t)mt * (16 * 3072) + 1024 + 32 * ks); qfa[mt][ks] = *(const GAS bf16x8*)(rp0 + (size_t)mt * (16 * 3072) + 32 * ks); }
        bf16* qkb = QK + (size_t)task * 4096 + (4 * q4) * 64 + l15;
        LAS float* Ab = A + (4 * q4) * 64 + l15;
#pragma unroll
        for (int mt = 0; mt < 4; ++mt) { const f32x4 gi4 = *(const LAS f32x4*)(gcs + 16 * mt + 4 * q4), bi4 = *(const LAS f32x4*)(bts + 16 * mt + 4 * q4);
#pragma unroll
            for (int nt = 0; nt < 4; ++nt) {
                if (nt <= mt) { const float gj = gcs[16 * nt + l15];
                    f32x4 akk = (f32x4){0.f, 0.f, 0.f, 0.f}, aqk = (f32x4){0.f, 0.f, 0.f, 0.f};
#pragma unroll
                    for (int ks = 0; ks < 4; ++ks) { akk = MFMA16(kf[mt][ks], kf[nt][ks], akk); aqk = MFMA16(qfa[mt][ks], kf[nt][ks], aqk); }
#pragma unroll
                    for (int rg = 0; rg < 4; ++rg) { const int i = 16 * mt + 4 * q4 + rg, j = 16 * nt + l15; const float dec = __expf(fminf(gi4[rg] - gj, 0.f));
                        Ab[(16 * mt + rg) * 64 + 16 * nt] = (i > j) ? bi4[rg] * akk[rg] * dec : 0.f;
                        qkb[(16 * mt + rg) * 64 + 16 * nt] = (bf16)f2bf((i >= j) ? aqk[rg] * dec : 0.f); }
                } else {
#pragma unroll
                    for (int rg = 0; rg < 4; ++rg) { Ab[(16 * mt + rg) * 64 + 16 * nt] = 0.f; qkb[(16 * mt + rg) * 64 + 16 * nt] = (bf16)0; }
                } }
            asm volatile("" ::: "memory"); }
        LDS_WAIT(); asm volatile("" ::: "memory");
        bf16* tg = TQ + (size_t)task * 4096 + lane;
        float Tc[64];
#pragma unroll
        for (int i = 0; i < 64; ++i) Tc[i] = 0.f;
#pragma unroll
        for (int i = 0; i < 64; ++i) { float s = (i == lane) ? 1.f : 0.f;
#pragma unroll
            for (int j4 = 0; j4 < i; j4 += 4) { const f32x4 a = *(const LAS f32x4*)(A + i * 64 + j4); s -= a[0] * Tc[j4]; s -= a[1] * Tc[j4 + 1]; s -= a[2] * Tc[j4 + 2]; s -= a[3] * Tc[j4 + 3]; }
            Tc[i] = s; tg[i * 64] = (bf16)f2bf(s);
            asm volatile("" ::: "memory"); }
        LDS_WAIT(); asm volatile("" ::: "memory");
    }
}

constexpr int SC_K = 0, SC_Q = 17408, SC_V = 34816, SC_T = 45056, SC_QK = 54272, SC_GC = 63488, SC_BT = 63744, SC_BUF = 64000;
constexpr int SC_OSC = 2 * SC_BUF;
static_assert(SC_OSC + 4 * 2048 <= RING_BYTES, "scan LDS");
constexpr int SGRP = 8, SLEN = 32;
constexpr size_t WS_MG = 216 * MiB;
constexpr size_t WS_BG = 220 * MiB;
__device__ __forceinline__ bf16x8 ld2x64(const LAS unsigned char* p) { const u32x2 a = *(const LAS u32x2*)p, b = *(const LAS u32x2*)(p + 32); return cat8(a, b); }
#define SC_BARRIER() asm volatile("s_waitcnt lgkmcnt(0)\n\ts_barrier" ::: "memory")
template <bool WV, bool WO>
__device__ __forceinline__ void scan_steps(Frame& F, const int head, const int n0, const int nsteps, const int colbase, f32x4 (&S)[8]) {
    const bf16* QKVD = (const bf16*)(F.ws + WS_QKVD); const bf16* TQ = (const bf16*)(F.ws + WS_TQ); const bf16* QK = (const bf16*)(F.ws + WS_QK);
    const float* GC = (const float*)(F.ws + WS_GC); const float* BETA = (const float*)(F.ws + WS_BETA);
    bf16* OD = (bf16*)((unsigned char*)F.out + DO_OD);
    const int lane = F.lane, w = F.wave, l15 = lane & 15, q4 = lane >> 4;
    const int tl = F.tid - 256;
    const int vloc = 16 * (w & 3), v0 = colbase + vloc;
    LAS unsigned char* L = F.lds + RING_OFF; LAS unsigned char* osc = L + SC_OSC + (w & 3) * 2048;
    v4u rk[4], rq[4], rv[2], rt[2], rqk[2]; float rs = 0.f;
#define SC_LOAD(n_) do { const int task_ = (n_) * 8 + head; \
        _Pragma("unroll") for (int i_ = 0; i_ < 4; ++i_) { const int id_ = tl + 256 * i_, row_ = id_ >> 4, pc_ = id_ & 15; const bf16* src_ = QKVD + (size_t)(64 * (n_) + row_) * 3072 + head * 128 + pc_ * 8; \
            rk[i_] = *(const GAS v4u*)(src_ + 1024); if (WO) rq[i_] = *(const GAS v4u*)(src_); } \
        _Pragma("unroll") for (int i_ = 0; i_ < 2; ++i_) { const int id_ = tl + 256 * i_; \
            if (WV) rv[i_] = *(const GAS v4u*)(QKVD + (size_t)(64 * (n_) + (id_ >> 3)) * 3072 + 2048 + head * 128 + colbase + (id_ & 7) * 8); \
            rt[i_] = *(const GAS v4u*)(TQ + (size_t)task_ * 4096 + id_ * 8); if (WO) rqk[i_] = *(const GAS v4u*)(QK + (size_t)task_ * 4096 + id_ * 8); } \
        if (tl < 64) rs = GC[(size_t)task_ * 64 + tl]; else if (tl < 128) rs = BETA[(size_t)(64 * (n_) + tl - 64) * 8 + head]; } while (0)
#define SC_WRITE(b_) do { LAS unsigned char* B_ = L + (b_) * SC_BUF; \
        _Pragma("unroll") for (int i_ = 0; i_ < 4; ++i_) { const int id_ = tl + 256 * i_, row_ = id_ >> 4, pc_ = id_ & 15; \
            *(LAS v4u*)(B_ + SC_K + row_ * 272 + pc_ * 16) = rk[i_]; if (WO) *(LAS v4u*)(B_ + SC_Q + row_ * 272 + pc_ * 16) = rq[i_]; } \
        _Pragma("unroll") for (int i_ = 0; i_ < 2; ++i_) { const int id_ = tl + 256 * i_; \
            if (WV) *(LAS v4u*)(B_ + SC_V + (id_ >> 3) * 160 + (id_ & 7) * 16) = rv[i_]; \
            *(LAS v4u*)(B_ + SC_T + (id_ >> 3) * 144 + (id_ & 7) * 16) = rt[i_]; if (WO) *(LAS v4u*)(B_ + SC_QK + (id_ >> 3) * 144 + (id_ & 7) * 16) = rqk[i_]; } \
        if (tl < 64) *(LAS float*)(B_ + SC_GC + tl * 4) = rs; else if (tl < 128) *(LAS float*)(B_ + SC_BT + (tl - 64) * 4) = rs; } while (0)
    if (w >= 4) { SC_LOAD(n0); SC_WRITE(0); }
    SC_BARRIER();
    for (int i = 0; i < nsteps; ++i) {
        if (w >= 4) {
            if (i + 1 < nsteps) { SC_LOAD(n0 + i + 1); SC_WRITE((i + 1) & 1); }
        } else {
            const int n = n0 + i;
            const LAS unsigned char* B = L + (i & 1) * SC_BUF;
            bf16x8 SB[4];
#pragma unroll
            for (int s = 0; s < 4; ++s) SB[s] = pack8f(S[2 * s], S[2 * s + 1]);
            f32x4 kS[4], qS[4];
#pragma unroll
            for (int mt = 0; mt < 4; ++mt) { kS[mt] = (f32x4){0.f, 0.f, 0.f, 0.f}; qS[mt] = (f32x4){0.f, 0.f, 0.f, 0.f};
#pragma unroll
                for (int s = 0; s < 4; ++s) { kS[mt] = MFMA16(ld2x64(B + SC_K + (16 * mt + l15) * 272 + 64 * s + 8 * q4), SB[s], kS[mt]);
                    if (WO) qS[mt] = MFMA16(ld2x64(B + SC_Q + (16 * mt + l15) * 272 + 64 * s + 8 * q4), SB[s], qS[mt]); } }
            const float gl = *(const LAS float*)(B + SC_GC + 63 * 4);
            f32x4 rhs[4], egc[4], edl[4];
#pragma unroll
            for (int mt = 0; mt < 4; ++mt) { const f32x4 g4 = *(const LAS f32x4*)(B + SC_GC + (16 * mt + 4 * q4) * 4), b4 = *(const LAS f32x4*)(B + SC_BT + (16 * mt + 4 * q4) * 4);
                f32x4 vv = (f32x4){0.f, 0.f, 0.f, 0.f};
                if (WV) { const u32x2 vt = tr16(B + SC_V + (16 * mt + 4 * q4 + (l15 >> 2)) * 160 + (vloc + 4 * (l15 & 3)) * 2); vv = (f32x4){bflo(vt.x), bfhi(vt.x), bflo(vt.y), bfhi(vt.y)}; }
#pragma unroll
                for (int rg = 0; rg < 4; ++rg) { egc[mt][rg] = __expf(g4[rg]); edl[mt][rg] = __expf(gl - g4[rg]); rhs[mt][rg] = b4[rg] * (vv[rg] - egc[mt][rg] * kS[mt][rg]); } }
            bf16x8 RB[2]; RB[0] = pack8f(rhs[0], rhs[1]); RB[1] = pack8f(rhs[2], rhs[3]);
            f32x4 uu[4];
#pragma unroll
            for (int mt = 0; mt < 4; ++mt) { uu[mt] = (f32x4){0.f, 0.f, 0.f, 0.f};
#pragma unroll
                for (int s = 0; s < 2; ++s) if (s <= (mt >> 1)) uu[mt] = MFMA16(ld2x64(B + SC_T + (16 * mt + l15) * 144 + 64 * s + 8 * q4), RB[s], uu[mt]); }
            if (WO) {
                bf16x8 UB[2]; UB[0] = pack8f(uu[0], uu[1]); UB[1] = pack8f(uu[2], uu[3]);
#pragma unroll
                for (int mt = 0; mt < 4; ++mt) { f32x4 o = egc[mt] * qS[mt];
#pragma unroll
                    for (int s = 0; s < 2; ++s) if (s <= (mt >> 1)) o = MFMA16(ld2x64(B + SC_QK + (16 * mt + l15) * 144 + 64 * s + 8 * q4), UB[s], o);
#pragma unroll
                    for (int rg = 0; rg < 4; ++rg) *(LAS unsigned short*)(osc + (16 * mt + 4 * q4 + rg) * 32 + l15 * 2) = (unsigned short)(cvtpk(o[rg], 0.f) & 0xffffu); }
                { const v4u o0 = *(const LAS v4u*)(osc + lane * 32), o1 = *(const LAS v4u*)(osc + lane * 32 + 16);
                    bf16* op = OD + (size_t)(64 * n + lane) * 1024 + head * 128 + v0; *(GAS v4u*)op = o0; *(GAS v4u*)(op + 8) = o1; }
            }
            bf16x8 DB[2]; DB[0] = pack8f(uu[0] * edl[0], uu[1] * edl[1]); DB[1] = pack8f(uu[2] * edl[2], uu[3] * edl[3]);
            const float egl = __expf(gl);
#pragma unroll
            for (int dt = 0; dt < 8; ++dt) { S[dt] = S[dt] * egl;
#pragma unroll
                for (int s = 0; s < 2; ++s) { const LAS unsigned char* kp = B + SC_K + (32 * s + 4 * q4 + (l15 >> 2)) * 272 + (16 * dt + 4 * (l15 & 3)) * 2;
                    S[dt] = MFMA16(cat8(tr16(kp), tr16(kp + 16 * 272)), DB[s], S[dt]); } }
        }
        SC_BARRIER();
    }
#undef SC_LOAD
#undef SC_WRITE
}
__device__ __forceinline__ void scan_pass1(Frame& F) {
    if (F.vcu >= 208) return;
    const int head = F.vcu / 26, r = F.vcu % 26, lane = F.lane, w = F.wave, l15 = lane & 15, q4 = lane >> 4;
    int g, qd; bool mpart;
    if (r < 2) { g = 0; qd = r; mpart = false; } else { g = 1 + ((r - 2) >> 2); const int sub = (r - 2) & 3; mpart = sub < 2; qd = sub & 1; }
    const int col = 64 * qd + 16 * (w & 3) + l15;
    f32x4 S[8];
#pragma unroll
    for (int dt = 0; dt < 8; ++dt)
#pragma unroll
        for (int rg = 0; rg < 4; ++rg) S[dt][rg] = (mpart && (16 * dt + 4 * q4 + rg == col)) ? 1.f : 0.f;
    if (mpart) scan_steps<false, false>(F, head, g * SLEN, SLEN, 64 * qd, S); else scan_steps<true, false>(F, head, g * SLEN, SLEN, 64 * qd, S);
    if (w < 4) {
        if (mpart) { bf16* mg = (bf16*)(F.ws + WS_MG) + ((size_t)(head * SGRP + g) * 128) * 128 + col;
#pragma unroll
            for (int dt = 0; dt < 8; ++dt)
#pragma unroll
                for (int rg = 0; rg < 4; ++rg) mg[(16 * dt + 4 * q4 + rg) * 128] = (bf16)f2bf(S[dt][rg]); }
        else { float* bg = (float*)(F.ws + WS_BG) + ((size_t)(head * SGRP + g) * 128) * 128 + col;
#pragma unroll
            for (int dt = 0; dt < 8; ++dt)
#pragma unroll
                for (int rg = 0; rg < 4; ++rg) bg[(16 * dt + 4 * q4 + rg) * 128] = S[dt][rg]; }
    }
}
__device__ __forceinline__ void scan_pass2(Frame& F) {
    if (F.vcu >= 128) return;
    const int head = F.vcu >> 4, g = (F.vcu & 15) >> 1, qd = F.vcu & 1, lane = F.lane, w = F.wave, l15 = lane & 15, q4 = lane >> 4;
    const int col = 64 * qd + 16 * (w & 3) + l15;
    f32x4 S[8];
#pragma unroll
    for (int dt = 0; dt < 8; ++dt) S[dt] = (f32x4){0.f, 0.f, 0.f, 0.f};
    if (w < 4 && g > 0) {
        const float* bg0 = (const float*)(F.ws + WS_BG) + ((size_t)(head * SGRP) * 128) * 128 + col;
#pragma unroll
        for (int dt = 0; dt < 8; ++dt)
#pragma unroll
            for (int rg = 0; rg < 4; ++rg) S[dt][rg] = bg0[(16 * dt + 4 * q4 + rg) * 128];
#pragma unroll 1
        for (int j = 1; j < g; ++j) {
            const float* bg = (const float*)(F.ws + WS_BG) + ((size_t)(head * SGRP + j) * 128) * 128 + col;
            const bf16* mg = (const bf16*)(F.ws + WS_MG) + ((size_t)(head * SGRP + j) * 128) * 128 + 4 * q4;
            bf16x8 SB[4];
#pragma unroll
            for (int s = 0; s < 4; ++s) SB[s] = pack8f(S[2 * s], S[2 * s + 1]);
#pragma unroll
            for (int dt = 0; dt < 8; ++dt) { f32x4 acc;
#pragma unroll
                for (int rg = 0; rg < 4; ++rg) acc[rg] = bg[(16 * dt + 4 * q4 + rg) * 128];
#pragma unroll
                for (int s = 0; s < 4; ++s) { const bf16* mp = mg + (size_t)(16 * dt + l15) * 128 + 32 * s; const u32x2 a = *(const GAS u32x2*)mp, b = *(const GAS u32x2*)(mp + 16); acc = MFMA16(cat8(a, b), SB[s], acc); }
                S[dt] = acc; }
        }
    }
    scan_steps<true, true>(F, head, g * SLEN, SLEN, 64 * qd, S);
}

__device__ __forceinline__ void finalize_delta_phase(Frame& F) {
    bf16* OD = (bf16*)((unsigned char*)F.out + DO_OD); const bf16* Z = (const bf16*)((unsigned char*)F.out + DO_Z);
    const int gw = F.vcu * NWAVES + F.wave, NGW = F.G * NWAVES, lane = F.lane;
    const int dc = (lane & 7) * 16;
    f32x4 dn[4];
#pragma unroll
    for (int i = 0; i < 4; ++i) dn[i] = *(const GAS f32x4*)(F.dn_norm + dc + 4 * i);
    for (int row = gw; row < SEQ; row += NGW) {
        const v4u o0 = *(const GAS v4u*)(OD + (size_t)row * 1024 + lane * 16), o1 = *(const GAS v4u*)(OD + (size_t)row * 1024 + lane * 16 + 8);
        const v4u z0 = *(const GAS v4u*)(Z + (size_t)row * 1024 + lane * 16), z1 = *(const GAS v4u*)(Z + (size_t)row * 1024 + lane * 16 + 8);
        float o[16], z[16];
#pragma unroll
        for (int i = 0; i < 4; ++i) { o[2 * i] = bflo(o0[i]); o[2 * i + 1] = bfhi(o0[i]); o[8 + 2 * i] = bflo(o1[i]); o[8 + 2 * i + 1] = bfhi(o1[i]);
            z[2 * i] = bflo(z0[i]); z[2 * i + 1] = bfhi(z0[i]); z[8 + 2 * i] = bflo(z1[i]); z[8 + 2 * i + 1] = bfhi(z1[i]); }
        float ss = 0.f;
#pragma unroll
        for (int i = 0; i < 16; ++i) ss += o[i] * o[i];
        ss += __shfl_xor(ss, 1); ss += __shfl_xor(ss, 2); ss += __shfl_xor(ss, 4);
        const float rs = 1.0f / sqrtf(ss * (1.0f / 128.0f) + EPS);
        v4u w0, w1;
#pragma unroll
        for (int i = 0; i < 4; ++i) { w0[i] = cvtpk(o[2 * i] * rs * dn[i >> 1][(2 * i) & 3] * z[2 * i], o[2 * i + 1] * rs * dn[i >> 1][(2 * i + 1) & 3] * z[2 * i + 1]);
            w1[i] = cvtpk(o[8 + 2 * i] * rs * dn[2 + (i >> 1)][(2 * i) & 3] * z[8 + 2 * i], o[8 + 2 * i + 1] * rs * dn[2 + (i >> 1)][(2 * i + 1) & 3] * z[8 + 2 * i + 1]); }
        *(GAS v4u*)(OD + (size_t)row * 1024 + lane * 16) = w0; *(GAS v4u*)(OD + (size_t)row * 1024 + lane * 16 + 8) = w1;
    }
}

__device__ __forceinline__ void final_norm_phase(Frame& F) {
    const float* SSQ = (const float*)(F.ws + WS_SSQ2);
    const int gw = F.vcu * NWAVES + F.wave, NGW = F.G * NWAVES, lane = F.lane;
    f32x4 nf[4];
#pragma unroll
    for (int j = 0; j < 4; ++j) nf[j] = ((const GAS f32x4*)F.norm_final)[lane + 64 * j];
    for (int row = gw; row < SEQ; row += NGW) {
        const f32x4* sp = (const f32x4*)(SSQ + (size_t)row * 16); const f32x4 s0 = sp[0], s1 = sp[1], s2 = sp[2], s3 = sp[3];
        const float ss = ((s0[0] + s0[1]) + (s0[2] + s0[3])) + ((s1[0] + s1[1]) + (s1[2] + s1[3])) + ((s2[0] + s2[1]) + (s2[2] + s2[3])) + ((s3[0] + s3[1]) + (s3[2] + s3[3]));
        const float rs = 1.0f / sqrtf(ss * (1.0f / 1024.0f) + EPS);
        GAS f32x4* hr = (GAS f32x4*)(F.out + (size_t)row * DM) + lane;
#pragma unroll
        for (int j = 0; j < 4; ++j) { const f32x4 v = hr[64 * j]; hr[64 * j] = v * rs * nf[j]; }
    }
}

#define GEMM_PHASE(EPI, A_, B_, N_, K_, ...) GEMM_PHASE_ON(F.G, (int)blockIdx.x, EPI, A_, B_, N_, K_, __VA_ARGS__)
#define GEMM_PHASE_ON(G_, C_, EPI, A_, B_, N_, K_, ...) do { pg8::Gemm g{(const bf16*)(A_), (const bf16*)(B_), SEQ, (N_), (K_)}; pg8::StaticOrder S; S.init(SEQ, (N_), (G_), (C_)); \
        pg8::EPI E{__VA_ARGS__}; pg8::gemm_phase<pg8::EPI, pg8::StaticOrder, true, true>(F.lds + RING_OFF, g, S, E); } while (0)
__device__ __forceinline__ void ph_gemm_qkva(Frame& F) {
    GEMM_PHASE(EpiStore, F.ws + WS_U, F.ws + WS_WIN, 4608, 1024, (bf16*)(F.ws + WS_QKVA), 4608); }
__device__ __forceinline__ void ph_gemm_qkvd(Frame& F) {
    GEMM_PHASE(EpiQkvd, F.ws + WS_U, (const bf16*)(F.ws + WS_WIN) + (size_t)4608 * 1024, 3072, 1024, (bf16*)(F.ws + WS_QKVD), (bf16*)(F.ws + WS_HALO)); }
__device__ __forceinline__ void ph_side_gemms(Frame& F) {
    const int Gs = F.G - 128, cs = F.vcu - 128;
    GEMM_PHASE_ON(Gs, cs, EpiSilu, F.ws + WS_U, (const bf16*)(F.ws + WS_WIN) + (size_t)7680 * 1024, 1024, 1024, (bf16*)((unsigned char*)F.out + DO_Z), 1024);
    p0_late_weights<1>(F, cs * NWAVES + F.wave, Gs * NWAVES);
}
__device__ __forceinline__ void ph_gemm_t1(Frame& F) {
    GEMM_PHASE(EpiStore, F.ws + WS_YA, F.ws + WS_WPA, 1024, 512, (bf16*)(F.ws + WS_T1), 1024); }
__device__ __forceinline__ void ph_gemm_t2(Frame& F) {
    GEMM_PHASE(EpiStore, (unsigned char*)F.out + DO_OD, F.ws + WS_WPD, 1024, 1024, (bf16*)(F.ws + WS_T2), 1024); }
__device__ __forceinline__ void ph_gemm_gate(Frame& F) {
    GEMM_PHASE(EpiGateMerge, F.ws + WS_U, (const bf16*)(F.ws + WS_WIN) + (size_t)8704 * 1024, 2048, 1024, (bf16*)(F.ws + WS_T1), (const bf16*)(F.ws + WS_T2)); }
__device__ __forceinline__ void ph_gemm_out(Frame& F) {
    GEMM_PHASE(EpiResid, F.ws + WS_T1, F.ws + WS_WOUT, 1024, 1024, F.x, F.out, (bf16*)(F.ws + WS_HB), (float*)(F.ws + WS_SSQ1)); }
__device__ __forceinline__ void ph_gemm_gu(Frame& F) {
    GEMM_PHASE(EpiSwiglu, F.ws + WS_HB, F.ws + WS_WGU, 5632, 1024, (bf16*)(F.ws + WS_ACT), (const float*)(F.ws + WS_SSQ1), EPS); }
__device__ __forceinline__ void ph_gemm_down(Frame& F) {
    GEMM_PHASE(EpiResid, F.ws + WS_ACT, F.ws + WS_WDN, 1024, 2816, F.out, F.out, nullptr, (float*)(F.ws + WS_SSQ2)); }

struct Args { const float* in[15]; float* out; unsigned char* ws; int ph_lo, ph_hi; };
__global__ void __launch_bounds__(NWAVES * 64, 2) hyb_fwd(Args args) {
    extern __shared__ __attribute__((aligned(16))) unsigned char lds[];
    Frame F;
    F.lds = (LAS unsigned char*)lds;
    F.MISC = (volatile LAS unsigned*)(F.lds + MISC_OFF);
    F.tid = threadIdx.x; F.lane = F.tid & 63; F.wave = __builtin_amdgcn_readfirstlane(F.tid >> 6);
    F.G = gridDim.x; { const int bx = blockIdx.x; F.vcu = (F.G % 8 == 0) ? (bx % 8) * (F.G / 8) + bx / 8 : bx; }
    unsigned char* ws = args.ws; F.ws = ws; F.out = args.out;
    F.ctl = (gu32*)(ws + WS_CTL);
    F.x = args.in[0]; F.norm_mix = args.in[1]; F.w_in = args.in[2]; F.conv_w = args.in[3]; F.a_log = args.in[4]; F.dt_bias = args.in[5]; F.dn_norm = args.in[6];
    F.w_pa = args.in[7]; F.w_pd = args.in[8]; F.w_out = args.in[9]; F.norm_ffn = args.in[10]; F.w_gate = args.in[11]; F.w_up = args.in[12]; F.w_down = args.in[13]; F.norm_final = args.in[14];
    for (int u = F.tid; u < (LDS_BYTES - LDSCTL_OFF) / 4; u += NWAVES * 64) ((LAS unsigned*)(F.lds + LDSCTL_OFF))[u] = 0u;
    __syncthreads();
    XcdBarrier bar; bar.bar = (unsigned*)(F.ctl + CW_BAR); bar.x = 0; bar.st = nullptr;
    if (!MK_SPLIT) bar = xcd_barrier_post((unsigned*)(F.ctl + CW_BAR), F.MISC + 8);
    const int lo = args.ph_lo, hi = args.ph_hi;
#ifdef ONLY_PH
#define IN(k) ((k) == ONLY_PH && lo <= (k) && (k) < hi)
#else
#define IN(k) (lo <= (k) && (k) < hi)
#endif
#define SEAM(k) do { if (IN(k) && IN((k) + 1)) xcd_barrier(bar); } while (0)
#ifndef REP_PH
#define REP_PH -1
#endif
#ifndef REP_N
#define REP_N 2
#endif
#define REPS(k) for (int rep_ = 0; rep_ < ((k) == REP_PH ? REP_N : 1); ++rep_)
#ifndef DUP_PH
#define DUP_PH -1
#endif
#define PHASE(k, CALL) do { if (IN(k)) { CALL; if (DUP_PH == (k)) { __syncthreads(); CALL; } } SEAM(k); } while (0)
    PHASE(0, p0_prologue(F));
    PHASE(1, ph_gemm_qkva(F));
    PHASE(2, attn_phase(F));
    PHASE(3, merge_phase(F));
    PHASE(4, ph_gemm_qkvd(F));
    PHASE(5, prep_phase(F));
    if (DUP_PH == 45) { xcd_barrier(bar); ph_gemm_qkvd(F); xcd_barrier(bar); prep_phase(F); xcd_barrier(bar); }
    PHASE(6, (F.vcu < 208 ? scan_pass1(F) : p0_late_weights<0>(F, (F.vcu - 208) * NWAVES + F.wave, (F.G - 208) * NWAVES)));
    PHASE(7, (F.vcu < 128 ? scan_pass2(F) : ph_side_gemms(F)));
    PHASE(8, finalize_delta_phase(F));
    PHASE(9, ph_gemm_t1(F));
    PHASE(10, ph_gemm_t2(F));
    PHASE(11, ph_gemm_gate(F));
    PHASE(12, ph_gemm_out(F));
    PHASE(13, ph_gemm_gu(F));
    PHASE(14, ph_gemm_down(F));
    PHASE(15, final_norm_phase(F));
#undef IN
#undef SEAM
#undef PHASE
}

extern "C" void kernel_launch(void* const* d_in, const int* in_sizes, int n_in, void* d_out, int out_size, void* d_ws, size_t ws_size, hipStream_t stream) {
    static int grid = 0;
    if (grid == 0) {
        if (n_in != 15 || in_sizes[0] != SEQ * DM || out_size != SEQ * DM || ws_size < WS_END) { fprintf(stderr, "kernel_launch: unexpected shapes (n_in %d, in0 %d, out %d, ws %zu)\n", n_in, n_in > 0 ? in_sizes[0] : -1, out_size, ws_size); grid = -1; return; }
        int dev = 0, cus = 0, per_cu = 0;
        if (hipGetDevice(&dev) != hipSuccess || hipDeviceGetAttribute(&cus, hipDeviceAttributeMultiprocessorCount, dev) != hipSuccess) { grid = -1; return; }
        if (hipFuncSetAttribute((const void*)hyb_fwd, hipFuncAttributeMaxDynamicSharedMemorySize, LDS_BYTES) != hipSuccess) { fprintf(stderr, "kernel_launch: hipFuncSetAttribute failed\n"); grid = -1; return; }
        if (hipOccupancyMaxActiveBlocksPerMultiprocessor(&per_cu, (const void*)hyb_fwd, NWAVES * 64, LDS_BYTES) != hipSuccess || per_cu < 1) { fprintf(stderr, "kernel_launch: occupancy query says %d\n", per_cu); per_cu = 1; }
        (void)hipGetLastError();
        grid = cus;
    }
    if (grid < 0) return;
    (void)hipMemsetAsync((char*)d_ws + WS_CTL, 0, CTL_ZERO_BYTES, stream);
    Args a{};
    for (int i = 0; i < 15; ++i) a.in[i] = (const float*)d_in[i];
    a.out = (float*)d_out; a.ws = (unsigned char*)d_ws;
#if MK_SPLIT
    for (int p = 0; p < N_PHASES; ++p) { a.ph_lo = p; a.ph_hi = p + 1; hipLaunchKernelGGL(hyb_fwd, dim3(grid), dim3(NWAVES * 64), LDS_BYTES, stream, a); }
#else
    a.ph_lo = 0; a.ph_hi = N_PHASES; hipLaunchKernelGGL(hyb_fwd, dim3(grid), dim3(NWAVES * 64), LDS_BYTES, stream, a);
#endif
}
```
